# Optimizing an MI355X kernel written in HIP

```python
import jax, jax.numpy as jnp
from jax import lax
import numpy as np

D_MODEL = 1024
BATCH = 8
SEQ = 4096
DEPTH = 1

D_A = D_MODEL
H_A = 8
GROUP_A = D_A // H_A
CHUNK_A = 128
H_B = 4
KEY_B = D_MODEL // 2
VAL_B = D_MODEL
DK_B = KEY_B // H_B
DV_B = VAL_B // H_B
GATE_RANK = 16
GATE_NORM = 16.0
CHUNK_B = 64
EPS = 1e-6
LN_EPS = 1e-5

N_IN = 3 * D_A + 2 * KEY_B + 2 * VAL_B + GATE_RANK + 2 * D_MODEL
SPLIT_POINTS = (
    D_A,
    2 * D_A,
    3 * D_A,
    3 * D_A + KEY_B,
    3 * D_A + 2 * KEY_B,
    3 * D_A + 2 * KEY_B + VAL_B,
    3 * D_A + 2 * KEY_B + 2 * VAL_B,
    3 * D_A + 2 * KEY_B + 2 * VAL_B + GATE_RANK,
)

kernel_name = 'hybrid_gmlp_gla_gated_parallel'


def _rmsnorm(x, g):
    xf = x.astype(jnp.float32)
    y = xf * lax.rsqrt(jnp.mean(xf * xf, axis=-1, keepdims=True) + EPS)
    return (y * g.astype(jnp.float32)).astype(x.dtype)


def _layernorm(x, g, b):
    xf = x.astype(jnp.float32)
    mu = jnp.mean(xf, axis=-1, keepdims=True)
    xc = xf - mu
    y = xc * lax.rsqrt(jnp.mean(xc * xc, axis=-1, keepdims=True) + LN_EPS)
    return (y * g.astype(jnp.float32) + b.astype(jnp.float32)).astype(x.dtype)


def _spatial_gating(u, v, ln_g, ln_b, w_s, b_s):
    bsz, seq, _ = u.shape
    n_chunks = seq // CHUNK_A
    v = _layernorm(v, ln_g, ln_b)
    vc = v.reshape(bsz, n_chunks, CHUNK_A, H_A, GROUP_A)
    causal = jnp.tril(jnp.ones((CHUNK_A, CHUNK_A), dtype=bool))
    w = jnp.where(causal, w_s, jnp.zeros_like(w_s)).astype(v.dtype)
    mixed = jnp.einsum('hts,bnshc->bnthc', w, vc) + b_s.T.astype(v.dtype)[None, None, :, :, None]
    return u * mixed.reshape(bsz, seq, D_A)


def _gla_chunk_step(state, inp):
    q, k, v, g = inp
    b = jnp.cumsum(g, axis=1)
    b_last = b[:, -1]
    b_mid = b[:, CHUNK_B // 2 - 1][:, None]
    q_i = q * jnp.exp(b - b_mid)
    k_i = k * jnp.exp(b_mid - b)
    scores = jnp.einsum('bthk,bshk->bhts', q_i, k_i)
    causal = jnp.tril(jnp.ones((CHUNK_B, CHUNK_B), dtype=bool))
    scores = jnp.where(causal, scores, 0.0)
    o = (jnp.einsum('bhts,bshv->bthv', scores, v)
         + jnp.einsum('bthk,bhkv->bthv', q * jnp.exp(b), state))
    k_s = k * jnp.exp(b_last[:, None] - b)
    state = jnp.exp(b_last)[..., None] * state + jnp.einsum('bshk,bshv->bhkv', k_s, v)
    return state, o


def _gla(q, k, v, g):
    bsz, seq, _ = q.shape
    n_chunks = seq // CHUNK_B

    def to_chunks(t, d):
        t = t.astype(jnp.float32).reshape(bsz, n_chunks, CHUNK_B, H_B, d)
        return jnp.transpose(t, (1, 0, 2, 3, 4))

    qc = to_chunks(q, DK_B) * (DK_B ** -0.5)
    kc = to_chunks(k, DK_B)
    vc = to_chunks(v, DV_B)
    gc = to_chunks(g, DK_B)
    state0 = jnp.zeros((bsz, H_B, DK_B, DV_B), jnp.float32)
    _, o = lax.scan(_gla_chunk_step, state0, (qc, kc, vc, gc))
    o = jnp.transpose(o, (1, 0, 2, 3, 4)).reshape(bsz, seq, H_B, DV_B)
    return o


def setup_inputs(seed: int = 0) -> dict:
    key = jax.random.key(seed)
    ks = jax.random.split(key, 16)
    f32 = jnp.float32
    nrm = lambda k, shape, s: jax.random.normal(k, shape, f32) * s
    return {
        'x': nrm(ks[0], (BATCH, SEQ, D_MODEL), 1.0),
        'norm_g': 1.0 + nrm(ks[1], (DEPTH, D_MODEL), 0.02),
        'w_in': nrm(ks[2], (DEPTH, D_MODEL, N_IN), D_MODEL ** -0.5),
        'ln_v_g': 1.0 + nrm(ks[3], (DEPTH, D_A), 0.02),
        'ln_v_b': nrm(ks[4], (DEPTH, D_A), 0.02),
        'w_spatial': nrm(ks[5], (DEPTH, H_A, CHUNK_A, CHUNK_A), 0.5 * CHUNK_A ** -0.5),
        'b_spatial': 1.0 + nrm(ks[6], (DEPTH, H_A, CHUNK_A), 0.02),
        'w_gate_up': nrm(ks[7], (DEPTH, GATE_RANK, KEY_B), GATE_RANK ** -0.5),
        'b_gate_up': nrm(ks[8], (DEPTH, KEY_B), 0.01),
        'gla_norm_g': 1.0 + nrm(ks[9], (DEPTH, DV_B), 0.02),
        'w_branch_a': nrm(ks[10], (DEPTH, D_A, D_MODEL), D_A ** -0.5),
        'w_branch_b': nrm(ks[11], (DEPTH, VAL_B, D_MODEL), VAL_B ** -0.5),
        'w_out': nrm(ks[12], (DEPTH, D_MODEL, D_MODEL), D_MODEL ** -0.5),
        'final_norm_g': 1.0 + nrm(ks[13], (D_MODEL,), 0.02),
    }


def reference(x, norm_g, w_in, ln_v_g, ln_v_b, w_spatial, b_spatial, w_gate_up, b_gate_up,
              gla_norm_g, w_branch_a, w_branch_b, w_out, final_norm_g):
    bsz, seq, _ = x.shape
    for l in range(DEPTH):
        h = _rmsnorm(x, norm_g[l])
        proj = h @ w_in[l]
        u, v, z_a, q, k, v_b, z_b, lr, gates = jnp.split(proj, SPLIT_POINTS, axis=-1)
        a = _spatial_gating(jax.nn.gelu(u, approximate=False), jax.nn.gelu(v, approximate=False),
                            ln_v_g[l], ln_v_b[l], w_spatial[l], b_spatial[l])
        a = a * jax.nn.silu(z_a)
        logit = (lr @ w_gate_up[l] + b_gate_up[l]).astype(jnp.float32)
        log_alpha = jax.nn.log_sigmoid(logit) / GATE_NORM
        o = _gla(q, k, v_b, log_alpha)
        o = _rmsnorm(o, gla_norm_g[l]).astype(x.dtype).reshape(bsz, seq, VAL_B)
        o = o * jax.nn.silu(z_b)
        g_a, g_b = jnp.split(jax.nn.sigmoid(gates), 2, axis=-1)
        merged = g_a * (a @ w_branch_a[l]) + g_b * (o @ w_branch_b[l])
        x = x + merged @ w_out[l]
    return _rmsnorm(x, final_norm_g)
```

```cpp
#include <hip/hip_runtime.h>
#include <hip/hip_cooperative_groups.h>
#include <cstdio>
#include <cstdint>
namespace cg = cooperative_groups;

#define LAS __attribute__((address_space(3)))
typedef unsigned short bf16_t;
typedef short bf16x8 __attribute__((ext_vector_type(8)));
typedef short s16x4 __attribute__((ext_vector_type(4)));
typedef float f32x4 __attribute__((ext_vector_type(4)));
typedef float f32x2 __attribute__((ext_vector_type(2)));
typedef unsigned u32x4 __attribute__((ext_vector_type(4)));
typedef unsigned u32x2 __attribute__((ext_vector_type(2)));

constexpr int NTOK = 32768, DM = 1024, SEQ = 4096, NIN = 8208;
constexpr int PJW = 7168;
constexpr int C_A = 0, C_O = 1024, C_GV = 2048, C_Q = 3072, C_K = 3584, C_SZB = 4096, C_GA = 5120, C_GB = 6144;
constexpr float RMS_EPS = 1e-6f, LN_EPS = 1e-5f;
constexpr size_t MiB = 1u << 20;
constexpr size_t WS_WINT = 1 * MiB, WS_WABT = 17 * MiB, WS_WOT = 21 * MiB, WS_WST = 23 * MiB, WS_LR = 24 * MiB, WS_PJ = 32 * MiB, WS_END = 480 * MiB;
constexpr int LDS_BYTES = 147456;

__device__ __forceinline__ float bf2f(unsigned b) { return __uint_as_float(b << 16); }
__device__ __forceinline__ float bflo(unsigned w) { return __uint_as_float(w << 16); }
__device__ __forceinline__ float bfhi(unsigned w) { return __uint_as_float(w & 0xffff0000u); }
__device__ __forceinline__ unsigned f2bf(float f) { unsigned u = __float_as_uint(f); return (u + 0x7fffu + ((u >> 16) & 1u)) >> 16; }
__device__ __forceinline__ unsigned pk2(float lo, float hi) { return f2bf(lo) | (f2bf(hi) << 16); }
__device__ __forceinline__ unsigned cvt_pk_bf16(float lo, float hi) { unsigned r; asm volatile("v_cvt_pk_bf16_f32 %0, %1, %2" : "=v"(r) : "v"(lo), "v"(hi)); return r; }
__device__ __forceinline__ float wave_sum(float v) {
#pragma unroll
    for (int o = 1; o < 64; o <<= 1) v += __shfl_xor(v, o);
    return v;
}
__device__ __forceinline__ float sigmoid_f(float x) { return __builtin_amdgcn_rcpf(1.0f + __builtin_amdgcn_exp2f(-1.44269504f * x)); }
__device__ __forceinline__ f32x2 gelu_pk(f32x2 v) {
    const f32x2 av = __builtin_elementwise_abs(v), d = av * 0.2316418882f + 1.0f;
    f32x2 t; t.x = __builtin_amdgcn_rcpf(d.x); t.y = __builtin_amdgcn_rcpf(d.y);
    f32x2 q = t * 0.5307027145f + (-0.7265760135f); q = q * t + 0.7107068705f; q = q * t + (-0.142248368f); q = q * t + 0.127414796f; q = q * t;
    const f32x2 s = (v * v) * (-0.72134752044f);
    f32x2 e; e.x = __builtin_amdgcn_exp2f(s.x); e.y = __builtin_amdgcn_exp2f(s.y);
    const f32x2 m = v * (q * e), r = v - m;
    f32x2 o; o.x = v.x < 0.f ? m.x : r.x; o.y = v.y < 0.f ? m.y : r.y; return o;
}
__device__ __forceinline__ f32x4 gelu4(f32x4 v) { f32x2 a = gelu_pk((f32x2){v[0], v[1]}), b = gelu_pk((f32x2){v[2], v[3]}); return (f32x4){a.x, a.y, b.x, b.y}; }
__device__ __forceinline__ f32x4 sigm4(f32x4 v) { return (f32x4){sigmoid_f(v[0]), sigmoid_f(v[1]), sigmoid_f(v[2]), sigmoid_f(v[3])}; }
__device__ __forceinline__ f32x4 silu4(f32x4 v) { return v * sigm4(v); }

struct Params {
    const float *x, *norm_g, *w_in, *ln_v_g, *ln_v_b, *w_spatial, *b_spatial, *w_gate_up, *b_gate_up, *gla_norm_g, *w_branch_a, *w_branch_b, *w_out, *final_norm_g;
    float* out; unsigned char* ws; int mask; int pad;
};

namespace pg8 {
constexpr int BM = 256, BK = 64, HALF = 128, HTB = HALF * BK * 2, STAGE_BYTES = 8 * HTB, NXCD = 8, WGM = 8;
__host__ __device__ __forceinline__ int lds_byte(int r, int c) { const int st = (r >> 4) * 2 + (c >> 5), rr = r & 15, cc = c & 31, ob = rr * 64 + cc * 2; return st * 1024 + (ob ^ (((ob >> 9) & 1) << 5)); }
__host__ __device__ __forceinline__ void stage_rc(int b, int& R, int& C) { const int st = b / 1024, sb = b % 1024, swz = sb ^ (((sb >> 9) & 1) << 5); R = (st >> 1) * 16 + swz / 64; C = (st & 1) * 32 + (swz % 64) / 2; }
__host__ __device__ __forceinline__ int perm32(int rho) { const int n = rho >> 4, i = rho & 15; return 8 * (i >> 2) + 4 * n + (i & 3); }

struct Unit { int pm, pn; };
struct Gemm { const bf16_t* A; const bf16_t* Bt; int M, N, K, lda, ldb; };

struct StaticOrder {
    int nM, nN, nwg, G, c;
    __host__ __device__ void init(int M, int N, int G_, int c_) { nM = M / BM; nN = N / BM; nwg = nM * nN; G = G_; c = c_; }
    __host__ __device__ bool next(int i, Unit& u) const {
        const long L = (long)i * G + c; if (L >= nwg) return false;
        int wgid = (int)L; { const int q = nwg / NXCD, r = nwg % NXCD, xcd = wgid % NXCD, off = wgid / NXCD; wgid = (xcd < r ? xcd * (q + 1) : r * (q + 1) + (xcd - r) * q) + off; }
        const int nig = WGM * nN, gid = wgid / nig, fm = gid * WGM, gsz = (nM - fm) < WGM ? (nM - fm) : WGM;
        u.pm = fm + ((wgid % nig) % gsz); u.pn = (wgid % nig) / gsz; return true;
    }
};

template <class Epi>
__device__ __forceinline__ void gemm_phase(LAS unsigned char* lds, const Gemm g, const StaticOrder& S, const Epi& E) {
    const int tid = threadIdx.x, wid = __builtin_amdgcn_readfirstlane(tid >> 6), lane = tid & 63, wr = wid >> 2, wc = wid & 3, fr = lane & 15, fq = lane >> 4;
    const int K = g.K, nt = K / BK;
    unsigned voffA[2], voffB[2];
#pragma unroll
    for (int i = 0; i < 2; ++i) { int R, C; stage_rc(tid * 16 + i * 8192, R, C); const int Rb = Epi::PERM ? ((R & ~31) + perm32(R & 31)) : R;
        voffA[i] = (unsigned)(R * g.lda + C) * 2u; voffB[i] = (unsigned)(Rb * g.ldb + C) * 2u; }
    const size_t kstep = (size_t)(BK * 2);
    const size_t hstepA = (size_t)HALF * g.lda * 2, hstepB = (size_t)HALF * g.ldb * 2;
    const size_t tstepA = 2 * hstepA, tstepB = 2 * hstepB;
    const unsigned ldsw = (unsigned)wid * 1024u;
    const int aoff = lds_byte(wr * 64 + fr, fq * 8), boff = lds_byte(wc * 32 + fr, fq * 8);
#define PG8_SA(b, h) (((b) * 2 + (h)) * HTB)
#define PG8_SB(b, h) ((4 + (b) * 2 + (h)) * HTB)
#define PG8_STAGE(bufoff, gbase, voff) do { _Pragma("unroll") for (int _i = 0; _i < 2; ++_i) \
        __builtin_amdgcn_global_load_lds((const unsigned*)((const char*)(gbase) + (voff)[_i]), (LAS unsigned*)(lds + (bufoff) + ldsw + _i * 8192), 16, 0, 0); } while (0)
#define PG8_LDA(dst, b, h) do { _Pragma("unroll") for (int m = 0; m < 4; ++m) _Pragma("unroll") for (int k = 0; k < 2; ++k) dst[m][k] = *(const LAS bf16x8*)(lds + PG8_SA(b, h) + aoff + m * 2048 + k * 1024); } while (0)
#define PG8_LDB(dst, b, h) do { _Pragma("unroll") for (int n = 0; n < 2; ++n) _Pragma("unroll") for (int k = 0; k < 2; ++k) dst[n][k] = *(const LAS bf16x8*)(lds + PG8_SB(b, h) + boff + n * 2048 + k * 1024); } while (0)
#define PG8_MMA(ai, bj, At, Bt) do { __builtin_amdgcn_s_setprio(1); _Pragma("unroll") for (int m = 0; m < 4; ++m) _Pragma("unroll") for (int n = 0; n < 2; ++n) _Pragma("unroll") for (int k = 0; k < 2; ++k) \
        acc[ai][bj][m][n] = __builtin_amdgcn_mfma_f32_16x16x32_bf16(Bt[n][k], At[m][k], acc[ai][bj][m][n], 0, 0, 0); __builtin_amdgcn_s_setprio(0); } while (0)
#define PG8_WAIT_V(n) asm volatile("s_waitcnt vmcnt(" #n ")" ::: "memory")
#define PG8_WAIT_L(n) asm volatile("s_waitcnt lgkmcnt(" #n ")" ::: "memory")
#define PG8_BAR __builtin_amdgcn_s_barrier()
#define PG8_SCHED __builtin_amdgcn_sched_barrier(0)
    Unit cur, nxt; int ui = 0;
    if (!S.next(0, cur)) return;
    f32x4 acc[2][2][4][2];
#pragma unroll
    for (int a = 0; a < 2; ++a)
#pragma unroll
        for (int b = 0; b < 2; ++b)
#pragma unroll
            for (int m = 0; m < 4; ++m)
#pragma unroll
                for (int n = 0; n < 2; ++n) acc[a][b][m][n] = (f32x4){0.f, 0.f, 0.f, 0.f};
    bf16x8 At[4][2], B0[2][2], B1[2][2];
    const char* cA = (const char*)g.A + (size_t)cur.pm * tstepA; const char* cB = (const char*)g.Bt + (size_t)cur.pn * tstepB;
    PG8_STAGE(PG8_SB(0, 0), cB, voffB); PG8_STAGE(PG8_SB(0, 1), cB + hstepB, voffB); PG8_STAGE(PG8_SA(0, 0), cA, voffA); PG8_STAGE(PG8_SA(0, 1), cA + hstepA, voffA);
    if (wr == 1) PG8_BAR;
    PG8_WAIT_V(2); PG8_BAR;
    PG8_STAGE(PG8_SB(1, 0), cB + kstep, voffB); PG8_STAGE(PG8_SA(1, 0), cA + kstep, voffA); PG8_STAGE(PG8_SB(1, 1), cB + hstepB + kstep, voffB);
    PG8_WAIT_V(6); PG8_BAR;
    for (;;) {
        const bool has_next = S.next(ui + 1, nxt);
        const char* nA = has_next ? (const char*)g.A + (size_t)nxt.pm * tstepA : cA; const char* nB = has_next ? (const char*)g.Bt + (size_t)nxt.pn * tstepB : cB;
        const int nh = Epi::MID ? 2 : 1, nth = nt / nh;
        for (int hf = 0; hf < nh; ++hf) {
        for (int t = hf * nth; t < (hf + 1) * nth; t += 2) {
            const bool last = (t == nt - 2);
            const char* a1 = cA + (size_t)(t + 1) * kstep;
            const char* a2 = last ? nA : cA + (size_t)(t + 2) * kstep; const char* b2 = last ? nB : cB + (size_t)(t + 2) * kstep;
            const char* a3 = a2 + kstep; const char* b3 = b2 + kstep;
            PG8_LDB(B0, 0, 0); PG8_LDB(B1, 0, 1); PG8_SCHED; PG8_LDA(At, 0, 0); PG8_STAGE(PG8_SA(1, 1), a1 + hstepA, voffA);
            PG8_WAIT_V(8); PG8_WAIT_L(0); PG8_BAR; PG8_MMA(0, 0, At, B0); PG8_MMA(0, 1, At, B1); PG8_BAR; PG8_SCHED;
            PG8_LDA(At, 0, 1); PG8_STAGE(PG8_SB(0, 0), b2, voffB); PG8_STAGE(PG8_SB(0, 1), b2 + hstepB, voffB); PG8_STAGE(PG8_SA(0, 0), a2, voffA);
            PG8_WAIT_V(8); PG8_WAIT_L(0); PG8_BAR; PG8_MMA(1, 0, At, B0); PG8_MMA(1, 1, At, B1); PG8_BAR; PG8_SCHED;
            PG8_LDB(B0, 1, 0); PG8_LDB(B1, 1, 1); PG8_SCHED; PG8_LDA(At, 1, 0); PG8_STAGE(PG8_SA(0, 1), a2 + hstepA, voffA);
            PG8_WAIT_V(8); PG8_WAIT_L(0); PG8_BAR; PG8_MMA(0, 0, At, B0); PG8_MMA(0, 1, At, B1); PG8_BAR; PG8_SCHED;
            PG8_LDA(At, 1, 1); PG8_STAGE(PG8_SB(1, 0), b3, voffB); PG8_STAGE(PG8_SB(1, 1), b3 + hstepB, voffB); PG8_STAGE(PG8_SA(1, 0), a3, voffA);
            PG8_WAIT_V(8); PG8_WAIT_L(0); PG8_BAR; PG8_MMA(1, 0, At, B0); PG8_MMA(1, 1, At, B1); PG8_BAR; PG8_SCHED;
        }
        if constexpr (Epi::MID) { if (hf == 0) E.mid(acc, cur, wr, wc, fr, fq); }
        }
        if (wr == 0) PG8_BAR;
        E(acc, cur, wr, wc, fr, fq);
        if (!has_next) break;
#pragma unroll
        for (int a = 0; a < 2; ++a)
#pragma unroll
            for (int b = 0; b < 2; ++b)
#pragma unroll
                for (int m = 0; m < 4; ++m)
#pragma unroll
                    for (int n = 0; n < 2; ++n) acc[a][b][m][n] = (f32x4){0.f, 0.f, 0.f, 0.f};
        cur = nxt; cA = nA; cB = nB; ++ui;
        if (wr == 1) PG8_BAR;
    }
    PG8_WAIT_V(0);
    PG8_BAR;
#undef PG8_SA
#undef PG8_SB
#undef PG8_STAGE
#undef PG8_LDA
#undef PG8_LDB
#undef PG8_MMA
#undef PG8_WAIT_V
#undef PG8_WAIT_L
#undef PG8_BAR
#undef PG8_SCHED
}
}

struct EpiProj {
    static constexpr bool PERM = true, MID = false;
    bf16_t* PJ;
    __device__ __forceinline__ void operator()(const f32x4 (&acc)[2][2][4][2], const pg8::Unit& u, int wr, int wc, int fr, int fq) const {
        const int row0 = u.pm * 256 + wr * 64 + fr; const int pn = u.pn;
        if (pn < 8) {
            bf16_t* base = PJ + C_A + 128 * pn + wc * 32 + 8 * fq;
#pragma unroll
            for (int ai = 0; ai < 2; ++ai)
#pragma unroll
                for (int m = 0; m < 4; ++m) {
                    bf16_t* rowp = base + (size_t)(row0 + ai * 128 + m * 16) * PJW;
                    const f32x4 v0 = gelu4(acc[ai][0][m][0]) * silu4(acc[ai][1][m][0]), v1 = gelu4(acc[ai][0][m][1]) * silu4(acc[ai][1][m][1]);
                    u32x4 w; w.x = cvt_pk_bf16(v0[0], v0[1]); w.y = cvt_pk_bf16(v0[2], v0[3]); w.z = cvt_pk_bf16(v1[0], v1[1]); w.w = cvt_pk_bf16(v1[2], v1[3]);
                    *(u32x4*)rowp = w;
                }
        } else {
            int act, dst;
            if (pn < 12) { act = 1; dst = C_GV + 256 * (pn - 8); }
            else if (pn < 14) { act = 4; dst = C_Q + 256 * (pn - 12); }
            else if (pn < 16) { act = 0; dst = C_K + 256 * (pn - 14); }
            else if (pn < 20) { act = 0; dst = C_O + 256 * (pn - 16); }
            else if (pn < 24) { act = 2; dst = C_SZB + 256 * (pn - 20); }
            else if (pn < 28) { act = 3; dst = C_GA + 256 * (pn - 24); }
            else { act = 3; dst = C_GB + 256 * (pn - 28); }
            bf16_t* base = PJ + dst + wc * 32 + 8 * fq;
#pragma unroll
            for (int ai = 0; ai < 2; ++ai)
#pragma unroll
                for (int m = 0; m < 4; ++m) {
                    bf16_t* rowp = base + (size_t)(row0 + ai * 128 + m * 16) * PJW;
#pragma unroll
                    for (int bj = 0; bj < 2; ++bj) {
                        f32x4 v0 = acc[ai][bj][m][0], v1 = acc[ai][bj][m][1];
                        if (act == 1) { v0 = gelu4(v0); v1 = gelu4(v1); }
                        else if (act == 2) { v0 = silu4(v0); v1 = silu4(v1); }
                        else if (act == 3) { v0 = sigm4(v0); v1 = sigm4(v1); }
                        else if (act == 4) { v0 = v0 * 0.08838834764831845f; v1 = v1 * 0.08838834764831845f; }
                        u32x4 w; w.x = cvt_pk_bf16(v0[0], v0[1]); w.y = cvt_pk_bf16(v0[2], v0[3]); w.z = cvt_pk_bf16(v1[0], v1[1]); w.w = cvt_pk_bf16(v1[2], v1[3]);
                        *(u32x4*)(rowp + bj * 128) = w;
                    }
                }
        }
    }
};
struct EpiMerged {
    static constexpr bool PERM = true, MID = true;
    bf16_t* PJ;
    __device__ __forceinline__ void mid(f32x4 (&acc)[2][2][4][2], const pg8::Unit& u, int wr, int wc, int fr, int fq) const {
        const int row0 = u.pm * 256 + wr * 64 + fr, col0 = u.pn * 256 + wc * 32 + 8 * fq;
        unsigned boff = (unsigned)row0 * (unsigned)(PJW * 2) + (unsigned)col0 * 2u; asm volatile("" : "+v"(boff));
#pragma unroll
        for (int ai = 0; ai < 2; ++ai)
#pragma unroll
            for (int m = 0; m < 4; ++m) {
                const bf16_t* rowp = (const bf16_t*)((const char*)PJ + (size_t)(boff + (unsigned)((ai * 128 + m * 16) * PJW * 2)));
#pragma unroll
                for (int bj = 0; bj < 2; ++bj) {
                    const u32x4 ga = *(const u32x4*)(rowp + C_GA + bj * 128), gb = *(const u32x4*)(rowp + C_GB + bj * 128);
                    f32x4 r0, r1;
                    r0[0] = bflo(ga.x) * __builtin_amdgcn_rcpf(fmaxf(bflo(gb.x), 1e-20f)); r0[1] = bfhi(ga.x) * __builtin_amdgcn_rcpf(fmaxf(bfhi(gb.x), 1e-20f));
                    r0[2] = bflo(ga.y) * __builtin_amdgcn_rcpf(fmaxf(bflo(gb.y), 1e-20f)); r0[3] = bfhi(ga.y) * __builtin_amdgcn_rcpf(fmaxf(bfhi(gb.y), 1e-20f));
                    r1[0] = bflo(ga.z) * __builtin_amdgcn_rcpf(fmaxf(bflo(gb.z), 1e-20f)); r1[1] = bfhi(ga.z) * __builtin_amdgcn_rcpf(fmaxf(bfhi(gb.z), 1e-20f));
                    r1[2] = bflo(ga.w) * __builtin_amdgcn_rcpf(fmaxf(bflo(gb.w), 1e-20f)); r1[3] = bfhi(ga.w) * __builtin_amdgcn_rcpf(fmaxf(bfhi(gb.w), 1e-20f));
                    acc[ai][bj][m][0] = acc[ai][bj][m][0] * r0; acc[ai][bj][m][1] = acc[ai][bj][m][1] * r1;
                }
                asm volatile("" ::: "memory");
            }
    }
    __device__ __forceinline__ void operator()(const f32x4 (&acc)[2][2][4][2], const pg8::Unit& u, int wr, int wc, int fr, int fq) const {
        const int row0 = u.pm * 256 + wr * 64 + fr, col0 = u.pn * 256 + wc * 32 + 8 * fq;
        unsigned boff = (unsigned)row0 * (unsigned)(PJW * 2) + (unsigned)col0 * 2u; asm volatile("" : "+v"(boff));
#pragma unroll
        for (int ai = 0; ai < 2; ++ai)
#pragma unroll
            for (int m = 0; m < 4; ++m) {
                bf16_t* rowp = (bf16_t*)((char*)PJ + (size_t)(boff + (unsigned)((ai * 128 + m * 16) * PJW * 2)));
#pragma unroll
                for (int bj = 0; bj < 2; ++bj) {
                    const u32x4 gb = *(const u32x4*)(rowp + C_GB + bj * 128);
                    const f32x4 v0 = acc[ai][bj][m][0] * (f32x4){bflo(gb.x), bfhi(gb.x), bflo(gb.y), bfhi(gb.y)}, v1 = acc[ai][bj][m][1] * (f32x4){bflo(gb.z), bfhi(gb.z), bflo(gb.w), bfhi(gb.w)};
                    u32x4 w; w.x = cvt_pk_bf16(v0[0], v0[1]); w.y = cvt_pk_bf16(v0[2], v0[3]); w.z = cvt_pk_bf16(v1[0], v1[1]); w.w = cvt_pk_bf16(v1[2], v1[3]);
                    *(u32x4*)(rowp + C_GV + bj * 128) = w;
                }
                asm volatile("" ::: "memory");
            }
    }
};
struct EpiOut {
    static constexpr bool PERM = false, MID = false;
    const float* x; float* out;
    __device__ __forceinline__ void operator()(const f32x4 (&acc)[2][2][4][2], const pg8::Unit& u, int wr, int wc, int fr, int fq) const {
        const int row0 = u.pm * 256 + wr * 64 + fr, col0 = u.pn * 256 + wc * 32 + 4 * fq;
#pragma unroll
        for (int ai = 0; ai < 2; ++ai)
#pragma unroll
            for (int m = 0; m < 4; ++m) {
                const size_t off = (size_t)(row0 + ai * 128 + m * 16) * DM + col0;
#pragma unroll
                for (int bj = 0; bj < 2; ++bj)
#pragma unroll
                    for (int n = 0; n < 2; ++n) { const f32x4 xs = *(const f32x4*)(x + off + bj * 128 + n * 16); *(f32x4*)(out + off + bj * 128 + n * 16) = xs + acc[ai][bj][m][n]; }
            }
    }
};

__device__ __forceinline__ void tr_item(const float* W, int ldw, int src_col0, int k0, bf16_t* dst, int ldd, int dst_row0, int dst_col0, LAS float* scr, int lane) {
#pragma unroll 8
    for (int i = 0; i < 32; ++i) { const int kk = 2 * i + (lane >> 5); scr[kk * 33 + (lane & 31)] = W[(size_t)(k0 + kk) * ldw + src_col0 + (lane & 31)]; }
    asm volatile("s_waitcnt lgkmcnt(0)" ::: "memory");
    const int c = lane & 7;
#pragma unroll
    for (int j = 0; j < 4; ++j) { const int n = (lane >> 3) + 8 * j; const LAS float* s = scr + (8 * c) * 33 + n;
        u32x4 o; o.x = pk2(s[0 * 33], s[1 * 33]); o.y = pk2(s[2 * 33], s[3 * 33]); o.z = pk2(s[4 * 33], s[5 * 33]); o.w = pk2(s[6 * 33], s[7 * 33]);
        *(u32x4*)(dst + (size_t)(dst_row0 + n) * ldd + dst_col0 + k0 + 8 * c) = o; }
    asm volatile("s_waitcnt lgkmcnt(0)" ::: "memory");
}
__device__ __forceinline__ int win_src_col(int pn, int jb) {
    const int j = 32 * jb;
    if (pn < 8) return j < 128 ? 128 * pn + j : 2048 + 128 * pn + (j - 128);
    if (pn < 12) return 1024 + 256 * (pn - 8) + j;
    if (pn < 14) return 3072 + 256 * (pn - 12) + j;
    if (pn < 16) return 3584 + 256 * (pn - 14) + j;
    if (pn < 20) return 4096 + 256 * (pn - 16) + j;
    if (pn < 24) return 5120 + 256 * (pn - 20) + j;
    if (pn < 28) return 6160 + 256 * (pn - 24) + j;
    return 7184 + 256 * (pn - 28) + j;
}
__device__ __forceinline__ void phase_prologue(const Params& P, LAS unsigned char* lds) {
    const int tid = threadIdx.x, lane = tid & 63, wave = tid >> 6, G = gridDim.x;
    const int gw = blockIdx.x * 8 + wave, NGW = G * 8;
    bf16_t* WinT = (bf16_t*)(P.ws + WS_WINT); bf16_t* WabT = (bf16_t*)(P.ws + WS_WABT); bf16_t* WoT = (bf16_t*)(P.ws + WS_WOT); bf16_t* WsT = (bf16_t*)(P.ws + WS_WST);
    float* LR = (float*)(P.ws + WS_LR); bf16_t* HB = (bf16_t*)P.out;
    LAS float* scr = (LAS float*)(lds + wave * 8704);
    LAS float* Wl = (LAS float*)(lds + 73728);
    for (int i = 0; i < 8; ++i) { const int idx = tid + 512 * i, k = idx >> 2, r4 = idx & 3;
        const f32x4 v = *(const f32x4*)(P.w_in + (size_t)k * NIN + 6144 + 4 * r4);
        Wl[(4 * r4 + 0) * 1024 + k] = v[0]; Wl[(4 * r4 + 1) * 1024 + k] = v[1]; Wl[(4 * r4 + 2) * 1024 + k] = v[2]; Wl[(4 * r4 + 3) * 1024 + k] = v[3]; }
    constexpr int I_IN = 16 * 256, I_B = 16 * 32;
    for (int it = gw; it < I_IN + 3 * I_B; it += NGW) {
        int r = it;
        if (r < I_IN) { const int kb = r >> 8, d = r & 255; tr_item(P.w_in, NIN, win_src_col(d >> 3, d & 7), 64 * kb, WinT, 1024, 32 * d, 0, scr, lane); continue; } r -= I_IN;
        if (r < I_B) { const int kb = r >> 5, nb = r & 31; tr_item(P.w_branch_a, 1024, 32 * nb, 64 * kb, WabT, 2048, 32 * nb, 0, scr, lane); continue; } r -= I_B;
        if (r < I_B) { const int kb = r >> 5, nb = r & 31; tr_item(P.w_branch_b, 1024, 32 * nb, 64 * kb, WabT, 2048, 32 * nb, 1024, scr, lane); continue; } r -= I_B;
        { const int kb = r >> 5, nb = r & 31; tr_item(P.w_out, 1024, 32 * nb, 64 * kb, WoT, 1024, 32 * nb, 0, scr, lane); }
    }
    for (int i = blockIdx.x * 512 + tid; i < 8 * 128 * 128 / 4; i += G * 512) {
        const int e = 4 * i, t = (e >> 7) & 127, s = e & 127; const f32x4 v = *(const f32x4*)(P.w_spatial + e);
        u32x2 o; o.x = pk2(s <= t ? v[0] : 0.f, s + 1 <= t ? v[1] : 0.f); o.y = pk2(s + 2 <= t ? v[2] : 0.f, s + 3 <= t ? v[3] : 0.f);
        *(u32x2*)(WsT + e) = o;
    }
    __syncthreads();
    f32x4 ng[4];
#pragma unroll
    for (int j = 0; j < 4; ++j) ng[j] = *(const f32x4*)(P.norm_g + 4 * lane + 256 * j);
    for (int m = gw; m < NTOK; m += NGW) {
        const f32x4* xr = (const f32x4*)(P.x + (size_t)m * DM) + lane;
        f32x4 v[4]; float ss = 0.f;
#pragma unroll
        for (int j = 0; j < 4; ++j) { v[j] = xr[64 * j]; ss += (v[j][0] * v[j][0] + v[j][1] * v[j][1]) + (v[j][2] * v[j][2] + v[j][3] * v[j][3]); }
        const float rstd = 1.0f / sqrtf(wave_sum(ss) * (1.0f / DM) + RMS_EPS);
        unsigned long long* o8 = (unsigned long long*)(HB + (size_t)m * DM) + lane;
#pragma unroll
        for (int j = 0; j < 4; ++j) { v[j] = v[j] * rstd * ng[j]; o8[64 * j] = (unsigned long long)pk2(v[j][0], v[j][1]) | ((unsigned long long)pk2(v[j][2], v[j][3]) << 32); }
        float mine = 0.f;
#pragma unroll 2
        for (int r = 0; r < 16; ++r) {
            float a = 0.f;
#pragma unroll
            for (int j = 0; j < 4; ++j) { const f32x4 w = *(const LAS f32x4*)(Wl + r * 1024 + 4 * lane + 256 * j); a += (v[j][0] * w[0] + v[j][1] * w[1]) + (v[j][2] * w[2] + v[j][3] * w[3]); }
            a = wave_sum(a); if (lane == r) mine = a;
        }
        if (lane < 16) LR[(size_t)m * 16 + lane] = mine;
    }
}

__device__ __forceinline__ void phase_mixer_a(const Params& P, LAS unsigned char* lds) {
    const int tid = threadIdx.x, lane = tid & 63, w = tid >> 6, g4 = lane >> 4, q = (lane & 15) >> 2, p = lane & 3;
    bf16_t* PJ = (bf16_t*)(P.ws + WS_PJ); const bf16_t* WsT = (const bf16_t*)(P.ws + WS_WST);
    constexpr int VN_P = 288, W_P = 272, W_OFF = 128 * VN_P, ST_OFF = W_OFF + 128 * W_P;
    LAS float* stats = (LAS float*)(lds + ST_OFF);
    for (int unit = blockIdx.x; unit < NTOK / 128; unit += gridDim.x) {
        const int r0 = unit * 128;
        for (int i = 0; i < 16; ++i) {
            const int s = 16 * w + i; const u32x4* gp = (const u32x4*)(PJ + (size_t)(r0 + s) * PJW + C_GV);
            const u32x4 a = gp[lane], b = gp[lane + 64];
            float x[16] = {bflo(a.x), bfhi(a.x), bflo(a.y), bfhi(a.y), bflo(a.z), bfhi(a.z), bflo(a.w), bfhi(a.w), bflo(b.x), bfhi(b.x), bflo(b.y), bfhi(b.y), bflo(b.z), bfhi(b.z), bflo(b.w), bfhi(b.w)};
            float sm = 0.f;
#pragma unroll
            for (int j = 0; j < 16; ++j) sm += x[j];
            const float mean = wave_sum(sm) * (1.0f / 1024.0f); float sq = 0.f;
#pragma unroll
            for (int j = 0; j < 16; ++j) { const float d = x[j] - mean; sq += d * d; }
            const float rstd = 1.0f / sqrtf(wave_sum(sq) * (1.0f / 1024.0f) + LN_EPS);
            if (lane == 0) { stats[2 * s] = mean; stats[2 * s + 1] = rstd; }
        }
        __syncthreads();
        for (int h = 0; h < 8; ++h) {
#pragma unroll
            for (int i = 0; i < 4; ++i) {
                const int item = tid + 512 * i, c8 = item & 15, s = item >> 4;
                const u32x4 gv = *(const u32x4*)(PJ + (size_t)(r0 + s) * PJW + C_GV + h * 128 + c8 * 8);
                const float mean = stats[2 * s], rstd = stats[2 * s + 1];
                const f32x4 g0 = *(const f32x4*)(P.ln_v_g + h * 128 + c8 * 8), g1 = *(const f32x4*)(P.ln_v_g + h * 128 + c8 * 8 + 4);
                const f32x4 b0 = *(const f32x4*)(P.ln_v_b + h * 128 + c8 * 8), b1 = *(const f32x4*)(P.ln_v_b + h * 128 + c8 * 8 + 4);
                u32x4 o;
                o.x = pk2((bflo(gv.x) - mean) * rstd * g0[0] + b0[0], (bfhi(gv.x) - mean) * rstd * g0[1] + b0[1]);
                o.y = pk2((bflo(gv.y) - mean) * rstd * g0[2] + b0[2], (bfhi(gv.y) - mean) * rstd * g0[3] + b0[3]);
                o.z = pk2((bflo(gv.z) - mean) * rstd * g1[0] + b1[0], (bfhi(gv.z) - mean) * rstd * g1[1] + b1[1]);
                o.w = pk2((bflo(gv.w) - mean) * rstd * g1[2] + b1[2], (bfhi(gv.w) - mean) * rstd * g1[3] + b1[3]);
                *(LAS u32x4*)(lds + s * VN_P + c8 * 16) = o;
                const u32x4 wv = *(const u32x4*)(WsT + h * 16384 + item * 8);
                *(LAS u32x4*)(lds + W_OFF + s * W_P + c8 * 16) = wv;
            }
            __syncthreads();
            f32x4 acc[8];
#pragma unroll
            for (int mt = 0; mt < 8; ++mt) acc[mt] = (f32x4){0.f, 0.f, 0.f, 0.f};
#pragma unroll
            for (int ks = 0; ks < 4; ++ks) {
                const unsigned a0 = (unsigned)((32 * ks + 8 * g4 + q) * VN_P + 32 * w + 8 * p);
                const s16x4 lo = __builtin_amdgcn_ds_read_tr16_b64_v4i16((LAS s16x4*)(lds + a0)), hi = __builtin_amdgcn_ds_read_tr16_b64_v4i16((LAS s16x4*)(lds + a0 + 4 * VN_P));
                const bf16x8 vf = (bf16x8){lo[0], lo[1], lo[2], lo[3], hi[0], hi[1], hi[2], hi[3]};
#pragma unroll
                for (int mt = 2 * ks; mt < 8; ++mt) {
                    const bf16x8 wf = *(const LAS bf16x8*)(lds + W_OFF + (16 * mt + (lane & 15)) * W_P + (32 * ks + 8 * g4) * 2);
                    acc[mt] = __builtin_amdgcn_mfma_f32_16x16x32_bf16(vf, wf, acc[mt], 0, 0, 0);
                }
            }
#pragma unroll
            for (int mt = 0; mt < 8; ++mt) {
                const int t = 16 * mt + (lane & 15);
                bf16_t* ptr = PJ + (size_t)(r0 + t) * PJW + C_A + h * 128 + 16 * w + 4 * g4;
                const u32x2 pv = *(const u32x2*)ptr; const float bs = P.b_spatial[h * 128 + t];
                u32x2 o; o.x = pk2(bflo(pv.x) * (acc[mt][0] + bs), bfhi(pv.x) * (acc[mt][1] + bs)); o.y = pk2(bflo(pv.y) * (acc[mt][2] + bs), bfhi(pv.y) * (acc[mt][3] + bs));
                *(u32x2*)ptr = o;
            }
            __syncthreads();
        }
    }
}

__device__ __forceinline__ void phase_gla_simple(const Params& P, LAS unsigned char* lds) {
    const int tid = threadIdx.x, lane = tid & 63, w = tid >> 6, kh = lane >> 5, v = 32 * w + (lane & 31);
    bf16_t* PJ = (bf16_t*)(P.ws + WS_PJ); const float* LR = (const float*)(P.ws + WS_LR);
    LAS float* Lq = (LAS float*)lds; LAS float* Lk = Lq + 32 * 128; LAS float* La = Lk + 32 * 128; LAS float* Lv = La + 32 * 128; LAS float* Lo = Lv + 32 * 256;
    for (int bh = blockIdx.x; bh < 32; bh += gridDim.x) {
        const int b = bh >> 2, h = bh & 3, kk = tid & 127;
        float wg[16];
#pragma unroll
        for (int r = 0; r < 16; ++r) wg[r] = P.w_gate_up[r * 512 + h * 128 + kk];
        const float bg = P.b_gate_up[h * 128 + kk];
        float S[64];
#pragma unroll
        for (int i = 0; i < 64; ++i) S[i] = 0.f;
        for (int c = 0; c < SEQ / 32; ++c) {
            const int row0 = b * SEQ + c * 32;
#pragma unroll
            for (int i = 0; i < 8; ++i) {
                const int t = (tid >> 7) + 4 * i; const size_t row = (size_t)(row0 + t);
                Lq[t * 128 + kk] = bf2f(PJ[row * PJW + C_Q + h * 128 + kk]); Lk[t * 128 + kk] = bf2f(PJ[row * PJW + C_K + h * 128 + kk]);
                float lg = bg; const f32x4* lr4 = (const f32x4*)(LR + row * 16);
#pragma unroll
                for (int r4 = 0; r4 < 4; ++r4) { const f32x4 l = lr4[r4]; lg += l[0] * wg[4 * r4] + l[1] * wg[4 * r4 + 1] + l[2] * wg[4 * r4 + 2] + l[3] * wg[4 * r4 + 3]; }
                const float ls = fminf(lg, 0.f) - log1pf(expf(-fabsf(lg)));
                La[t * 128 + kk] = expf(ls * (1.0f / 16.0f));
            }
#pragma unroll
            for (int i = 0; i < 16; ++i) { const int idx = tid + 512 * i, t = idx >> 8, vv = idx & 255; Lv[t * 256 + vv] = bf2f(PJ[(size_t)(row0 + t) * PJW + C_O + h * 256 + vv]); }
            __syncthreads();
            for (int t = 0; t < 32; ++t) {
                const float vt = Lv[t * 256 + v]; float part = 0.f;
#pragma unroll
                for (int i4 = 0; i4 < 16; ++i4) {
                    const f32x4 a = *(const LAS f32x4*)(La + t * 128 + 64 * kh + 4 * i4), k4 = *(const LAS f32x4*)(Lk + t * 128 + 64 * kh + 4 * i4), q4 = *(const LAS f32x4*)(Lq + t * 128 + 64 * kh + 4 * i4);
#pragma unroll
                    for (int e = 0; e < 4; ++e) { S[4 * i4 + e] = a[e] * S[4 * i4 + e] + k4[e] * vt; part += q4[e] * S[4 * i4 + e]; }
                }
                part += __shfl_xor(part, 32);
                if (kh == 0) Lo[t * 256 + v] = part;
            }
            __syncthreads();
#pragma unroll
            for (int i = 0; i < 4; ++i) {
                const int t = 4 * w + i; const f32x4 o = *(const LAS f32x4*)(Lo + t * 256 + 4 * lane);
                const float ss = wave_sum((o[0] * o[0] + o[1] * o[1]) + (o[2] * o[2] + o[3] * o[3]));
                const float rstd = 1.0f / sqrtf(ss * (1.0f / 256.0f) + RMS_EPS);
                const f32x4 gn = *(const f32x4*)(P.gla_norm_g + 4 * lane);
                const size_t base = (size_t)(row0 + t) * PJW + h * 256 + 4 * lane;
                const u32x2 z = *(const u32x2*)(PJ + base + C_SZB);
                u32x2 r; r.x = pk2(o[0] * rstd * gn[0] * bflo(z.x), o[1] * rstd * gn[1] * bfhi(z.x)); r.y = pk2(o[2] * rstd * gn[2] * bflo(z.y), o[3] * rstd * gn[3] * bfhi(z.y));
                *(u32x2*)(PJ + base + C_O) = r;
            }
            __syncthreads();
        }
    }
}

__device__ __forceinline__ void phase_final_norm(const Params& P) {
    const int tid = threadIdx.x, lane = tid & 63, wave = tid >> 6;
    const int gw = blockIdx.x * 8 + wave, NGW = gridDim.x * 8;
    f32x4 ng[4];
#pragma unroll
    for (int j = 0; j < 4; ++j) ng[j] = *(const f32x4*)(P.final_norm_g + 4 * lane + 256 * j);
    for (int m = gw; m < NTOK; m += NGW) {
        f32x4* xr = (f32x4*)(P.out + (size_t)m * DM) + lane;
        f32x4 v[4]; float ss = 0.f;
#pragma unroll
        for (int j = 0; j < 4; ++j) { v[j] = xr[64 * j]; ss += (v[j][0] * v[j][0] + v[j][1] * v[j][1]) + (v[j][2] * v[j][2] + v[j][3] * v[j][3]); }
        const float rstd = 1.0f / sqrtf(wave_sum(ss) * (1.0f / DM) + RMS_EPS);
#pragma unroll
        for (int j = 0; j < 4; ++j) xr[64 * j] = v[j] * rstd * ng[j];
    }
}

template <int PH> __device__ __forceinline__ void run_phase(const Params& P, LAS unsigned char* lds) {
    if constexpr (PH == 0) phase_prologue(P, lds);
    if constexpr (PH == 1) { pg8::Gemm g{(const bf16_t*)P.out, (const bf16_t*)(P.ws + WS_WINT), NTOK, 8192, 1024, 1024, 1024}; pg8::StaticOrder S; S.init(NTOK, 8192, gridDim.x, blockIdx.x);
        EpiProj E{(bf16_t*)(P.ws + WS_PJ)}; pg8::gemm_phase<EpiProj>(lds, g, S, E); }
    if constexpr (PH == 2) phase_mixer_a(P, lds);
    if constexpr (PH == 3) phase_gla_simple(P, lds);
    if constexpr (PH == 4) { pg8::Gemm g{(const bf16_t*)(P.ws + WS_PJ) + C_A, (const bf16_t*)(P.ws + WS_WABT), NTOK, 1024, 2048, PJW, 2048}; pg8::StaticOrder S; S.init(NTOK, 1024, gridDim.x, blockIdx.x);
        EpiMerged E{(bf16_t*)(P.ws + WS_PJ)}; pg8::gemm_phase<EpiMerged>(lds, g, S, E); }
    if constexpr (PH == 5) { pg8::Gemm g{(const bf16_t*)(P.ws + WS_PJ) + C_GV, (const bf16_t*)(P.ws + WS_WOT), NTOK, 1024, 1024, PJW, 1024}; pg8::StaticOrder S; S.init(NTOK, 1024, gridDim.x, blockIdx.x);
        EpiOut E{P.x, P.out}; pg8::gemm_phase<EpiOut>(lds, g, S, E); }
    if constexpr (PH == 6) phase_final_norm(P);
}

template <int PH> __global__ void __launch_bounds__(512, 2) k_phase(Params P) {
    extern __shared__ __attribute__((aligned(16))) unsigned char shm[];
    run_phase<PH>(P, (LAS unsigned char*)shm);
}

template <class F> static void launch_one(F f, int grid, const Params& p, hipStream_t stream) {
    hipFuncSetAttribute((const void*)f, hipFuncAttributeMaxDynamicSharedMemorySize, LDS_BYTES);
    hipLaunchKernelGGL(f, dim3(grid), dim3(512), LDS_BYTES, stream, p);
}

extern "C" void kernel_launch(void* const* d_in, const int* in_sizes, int n_in, void* d_out, int out_size, void* d_ws, size_t ws_size, hipStream_t stream) {
    if (n_in != 14 || ws_size < WS_END) { fprintf(stderr, "kernel_launch: unexpected n_in %d or ws_size %zu (need %zu)\n", n_in, ws_size, (size_t)WS_END); return; }
    Params p{};
    p.x = (const float*)d_in[0]; p.norm_g = (const float*)d_in[1]; p.w_in = (const float*)d_in[2]; p.ln_v_g = (const float*)d_in[3]; p.ln_v_b = (const float*)d_in[4];
    p.w_spatial = (const float*)d_in[5]; p.b_spatial = (const float*)d_in[6]; p.w_gate_up = (const float*)d_in[7]; p.b_gate_up = (const float*)d_in[8]; p.gla_norm_g = (const float*)d_in[9];
    p.w_branch_a = (const float*)d_in[10]; p.w_branch_b = (const float*)d_in[11]; p.w_out = (const float*)d_in[12]; p.final_norm_g = (const float*)d_in[13];
    p.out = (float*)d_out; p.ws = (unsigned char*)d_ws; p.mask = 0; p.pad = 0;
    const int grid = 256;
    launch_one(k_phase<0>, grid, p, stream);
    launch_one(k_phase<1>, grid, p, stream);
    launch_one(k_phase<2>, grid, p, stream);
    launch_one(k_phase<3>, grid, p, stream);
    launch_one(k_phase<4>, grid, p, stream);
    launch_one(k_phase<5>, grid, p, stream);
    launch_one(k_phase<6>, grid, p, stream);
}
```

```cpp
#include <hip/hip_runtime.h>
#include <hip/hip_cooperative_groups.h>
#include <cstdio>
#include <cstdint>
namespace cg = cooperative_groups;

#define LAS __attribute__((address_space(3)))
typedef unsigned short bf16_t;
typedef short bf16x8 __attribute__((ext_vector_type(8)));
typedef short s16x4 __attribute__((ext_vector_type(4)));
typedef float f32x4 __attribute__((ext_vector_type(4)));
typedef float f32x2 __attribute__((ext_vector_type(2)));
typedef unsigned u32x4 __attribute__((ext_vector_type(4)));
typedef unsigned u32x2 __attribute__((ext_vector_type(2)));

constexpr int NTOK = 32768, DM = 1024, SEQ = 4096, NIN = 8208;
constexpr int PJW = 7168;
constexpr int C_A = 0, C_O = 1024, C_GV = 2048, C_Q = 3072, C_K = 3584, C_SZB = 4096, C_GA = 5120, C_GB = 6144;
constexpr size_t T_P = 0, T_GV = (size_t)NTOK * 1024, T_Q = 2 * (size_t)NTOK * 1024, T_K = T_Q + (size_t)NTOK * 512, T_VB = T_K + (size_t)NTOK * 512, T_ZB = T_VB + (size_t)NTOK * 1024, T_GA = T_ZB + (size_t)NTOK * 1024, T_GB = T_GA + (size_t)NTOK * 1024;
constexpr float RMS_EPS = 1e-6f, LN_EPS = 1e-5f;
constexpr size_t MiB = 1u << 20;
constexpr size_t WS_WINT = 1 * MiB, WS_WABT = 17 * MiB, WS_WOT = 21 * MiB, WS_WST = 23 * MiB, WS_LR = 24 * MiB, WS_DEC = 26 * MiB, WS_PJ = 32 * MiB, WS_PB = 480 * MiB, WS_SL = 496 * MiB, WS_END = 508 * MiB;
constexpr size_t WS_XB = 28 * MiB, WS_CNT = 29 * MiB;
constexpr size_t WS_DL = 27 * MiB, WS_FLAG = 27 * MiB + 512 * 1024;
constexpr int LDS_BYTES = 153600;

__device__ __forceinline__ float bf2f(unsigned b) { return __uint_as_float(b << 16); }
__device__ __forceinline__ float bflo(unsigned w) { return __uint_as_float(w << 16); }
__device__ __forceinline__ float bfhi(unsigned w) { return __uint_as_float(w & 0xffff0000u); }
__device__ __forceinline__ unsigned f2bf(float f) { unsigned u = __float_as_uint(f); return (u + 0x7fffu + ((u >> 16) & 1u)) >> 16; }
__device__ __forceinline__ unsigned pk2(float lo, float hi) { return f2bf(lo) | (f2bf(hi) << 16); }
__device__ __forceinline__ unsigned cvt_pk_bf16(float lo, float hi) { unsigned r; asm volatile("v_cvt_pk_bf16_f32 %0, %1, %2" : "=v"(r) : "v"(lo), "v"(hi)); return r; }
__device__ __forceinline__ int opaque_tid() { int t = threadIdx.x; asm volatile("" : "+v"(t)); return t; }
__device__ __forceinline__ float wave_sum(float v) {
#pragma unroll
    for (int o = 1; o < 64; o <<= 1) v += __shfl_xor(v, o);
    return v;
}
__device__ __forceinline__ float sigmoid_f(float x) { return __builtin_amdgcn_rcpf(1.0f + __builtin_amdgcn_exp2f(-1.44269504f * x)); }
__device__ __forceinline__ f32x2 gelu_pk(f32x2 v) {
    const f32x2 av = __builtin_elementwise_abs(v), d = av * 0.2316418882f + 1.0f;
    f32x2 t; t.x = __builtin_amdgcn_rcpf(d.x); t.y = __builtin_amdgcn_rcpf(d.y);
    f32x2 q = t * 0.5307027145f + (-0.7265760135f); q = q * t + 0.7107068705f; q = q * t + (-0.142248368f); q = q * t + 0.127414796f; q = q * t;
    const f32x2 s = (v * v) * (-0.72134752044f);
    f32x2 e; e.x = __builtin_amdgcn_exp2f(s.x); e.y = __builtin_amdgcn_exp2f(s.y);
    const f32x2 m = v * (q * e), r = v - m;
    f32x2 o; o.x = v.x < 0.f ? m.x : r.x; o.y = v.y < 0.f ? m.y : r.y; return o;
}
__device__ __forceinline__ f32x4 gelu4(f32x4 v) { f32x2 a = gelu_pk((f32x2){v[0], v[1]}), b = gelu_pk((f32x2){v[2], v[3]}); return (f32x4){a.x, a.y, b.x, b.y}; }
__device__ __forceinline__ f32x4 sigm4(f32x4 v) { return (f32x4){sigmoid_f(v[0]), sigmoid_f(v[1]), sigmoid_f(v[2]), sigmoid_f(v[3])}; }
__device__ __forceinline__ f32x4 silu4(f32x4 v) { return v * sigm4(v); }

struct Params {
    const float *x, *norm_g, *w_in, *ln_v_g, *ln_v_b, *w_spatial, *b_spatial, *w_gate_up, *b_gate_up, *gla_norm_g, *w_branch_a, *w_branch_b, *w_out, *final_norm_g;
    float* out; unsigned char* ws; int mask; int pad;
};

namespace pg8 {
constexpr int BM = 256, BK = 64, HALF = 128, HTB = HALF * BK * 2, STAGE_BYTES = 8 * HTB, NXCD = 8, WGM = 8;
__host__ __device__ __forceinline__ int lds_byte(int r, int c) { const int st = (r >> 4) * 2 + (c >> 5), rr = r & 15, cc = c & 31, ob = rr * 64 + cc * 2; return st * 1024 + (ob ^ (((ob >> 9) & 1) << 5)); }
__host__ __device__ __forceinline__ void stage_rc(int b, int& R, int& C) { const int st = b / 1024, sb = b % 1024, swz = sb ^ (((sb >> 9) & 1) << 5); R = (st >> 1) * 16 + swz / 64; C = (st & 1) * 32 + (swz % 64) / 2; }
__host__ __device__ __forceinline__ int perm32(int rho) { const int n = rho >> 4, i = rho & 15; return 8 * (i >> 2) + 4 * n + (i & 3); }

struct Unit { int pm, pn; };
struct Gemm { const bf16_t* A; const bf16_t* Bt; int M, N, K, lda, ldb; };

struct StaticOrder {
    int nM, nN, nwg, G, c;
    __host__ __device__ void init(int M, int N, int G_, int c_) { nM = M / BM; nN = N / BM; nwg = nM * nN; G = G_; c = c_; }
    __host__ __device__ bool next(int i, Unit& u) const {
        const long L = (long)i * G + c; if (L >= nwg) return false;
        int wgid = (int)L; { const int q = nwg / NXCD, r = nwg % NXCD, xcd = wgid % NXCD, off = wgid / NXCD; wgid = (xcd < r ? xcd * (q + 1) : r * (q + 1) + (xcd - r) * q) + off; }
        const int nig = WGM * nN, gid = wgid / nig, fm = gid * WGM, gsz = (nM - fm) < WGM ? (nM - fm) : WGM;
        u.pm = fm + ((wgid % nig) % gsz); u.pn = (wgid % nig) / gsz; return true;
    }
};

template <class Epi>
__device__ __forceinline__ void gemm_phase(LAS unsigned char* lds, const Gemm g, const StaticOrder& S, const Epi& E) {
    const int tid = opaque_tid(), wid = __builtin_amdgcn_readfirstlane(tid >> 6), lane = tid & 63, wr = wid >> 2, wc = wid & 3, fr = lane & 15, fq = lane >> 4;
    const int K = g.K, nt = K / BK;
    unsigned voffA[2], voffB[2];
#pragma unroll
    for (int i = 0; i < 2; ++i) { int R, C; stage_rc(tid * 16 + i * 8192, R, C); const int Rb = Epi::PERM ? ((R & ~31) + perm32(R & 31)) : R;
        voffA[i] = (unsigned)(R * g.lda + C) * 2u; voffB[i] = (unsigned)(Rb * g.ldb + C) * 2u; }
    const size_t kstep = (size_t)(BK * 2);
    const size_t hstepA = (size_t)HALF * g.lda * 2, hstepB = (size_t)HALF * g.ldb * 2;
    const size_t tstepA = 2 * hstepA, tstepB = 2 * hstepB;
    const unsigned ldsw = (unsigned)wid * 1024u;
    const int aoff = lds_byte(wr * 64 + fr, fq * 8), boff = lds_byte(wc * 32 + fr, fq * 8);
#define PG8_SA(b, h) (((b) * 2 + (h)) * HTB)
#define PG8_SB(b, h) ((4 + (b) * 2 + (h)) * HTB)
#define PG8_STAGE(bufoff, gbase, voff) do { _Pragma("unroll") for (int _i = 0; _i < 2; ++_i) \
        __builtin_amdgcn_global_load_lds((const unsigned*)((const char*)(gbase) + (voff)[_i]), (LAS unsigned*)(lds + (bufoff) + ldsw + _i * 8192), 16, 0, 0); } while (0)
#define PG8_LDA(dst, b, h) do { _Pragma("unroll") for (int m = 0; m < 4; ++m) _Pragma("unroll") for (int k = 0; k < 2; ++k) dst[m][k] = *(const LAS bf16x8*)(lds + PG8_SA(b, h) + aoff + m * 2048 + k * 1024); } while (0)
#define PG8_LDB(dst, b, h) do { _Pragma("unroll") for (int n = 0; n < 2; ++n) _Pragma("unroll") for (int k = 0; k < 2; ++k) dst[n][k] = *(const LAS bf16x8*)(lds + PG8_SB(b, h) + boff + n * 2048 + k * 1024); } while (0)
#define PG8_MMA(ai, bj, At, Bt) do { __builtin_amdgcn_s_setprio(1); _Pragma("unroll") for (int m = 0; m < 4; ++m) _Pragma("unroll") for (int n = 0; n < 2; ++n) _Pragma("unroll") for (int k = 0; k < 2; ++k) \
        acc[ai][bj][m][n] = __builtin_amdgcn_mfma_f32_16x16x32_bf16(Bt[n][k], At[m][k], acc[ai][bj][m][n], 0, 0, 0); __builtin_amdgcn_s_setprio(0); } while (0)
#define PG8_WAIT_V(n) asm volatile("s_waitcnt vmcnt(" #n ")" ::: "memory")
#define PG8_WAIT_L(n) asm volatile("s_waitcnt lgkmcnt(" #n ")" ::: "memory")
#define PG8_BAR __builtin_amdgcn_s_barrier()
#define PG8_SCHED __builtin_amdgcn_sched_barrier(0)
    Unit cur, nxt; int ui = 0;
    if (!S.next(0, cur)) return;
    f32x4 acc[2][2][4][2];
#pragma unroll
    for (int a = 0; a < 2; ++a)
#pragma unroll
        for (int b = 0; b < 2; ++b)
#pragma unroll
            for (int m = 0; m < 4; ++m)
#pragma unroll
                for (int n = 0; n < 2; ++n) acc[a][b][m][n] = (f32x4){0.f, 0.f, 0.f, 0.f};
    bf16x8 At[4][2], B0[2][2], B1[2][2];
    const char* cA = (const char*)g.A + (size_t)cur.pm * tstepA; const char* cB = (const char*)g.Bt + (size_t)cur.pn * tstepB;
    PG8_STAGE(PG8_SB(0, 0), cB, voffB); PG8_STAGE(PG8_SB(0, 1), cB + hstepB, voffB); PG8_STAGE(PG8_SA(0, 0), cA, voffA); PG8_STAGE(PG8_SA(0, 1), cA + hstepA, voffA);
    if (wr == 1) PG8_BAR;
    PG8_WAIT_V(2); PG8_BAR;
    PG8_STAGE(PG8_SB(1, 0), cB + kstep, voffB); PG8_STAGE(PG8_SA(1, 0), cA + kstep, voffA); PG8_STAGE(PG8_SB(1, 1), cB + hstepB + kstep, voffB);
    PG8_WAIT_V(6); PG8_BAR;
    for (;;) {
        const bool has_next = S.next(ui + 1, nxt);
        const char* nA = has_next ? (const char*)g.A + (size_t)nxt.pm * tstepA : cA; const char* nB = has_next ? (const char*)g.Bt + (size_t)nxt.pn * tstepB : cB;
        const int nh = Epi::MID ? 2 : 1, nth = nt / nh;
        for (int hf = 0; hf < nh; ++hf) {
        for (int t = hf * nth; t < (hf + 1) * nth; t += 2) {
            const bool last = (t == nt - 2);
            const char* a1 = cA + (size_t)(t + 1) * kstep;
            const char* a2 = last ? nA : cA + (size_t)(t + 2) * kstep; const char* b2 = last ? nB : cB + (size_t)(t + 2) * kstep;
            const char* a3 = a2 + kstep; const char* b3 = b2 + kstep;
            PG8_LDB(B0, 0, 0); PG8_LDB(B1, 0, 1); PG8_SCHED; PG8_LDA(At, 0, 0); PG8_STAGE(PG8_SA(1, 1), a1 + hstepA, voffA);
            PG8_WAIT_V(8); PG8_WAIT_L(0); PG8_BAR; PG8_MMA(0, 0, At, B0); PG8_MMA(0, 1, At, B1); PG8_BAR; PG8_SCHED;
            PG8_LDA(At, 0, 1); PG8_STAGE(PG8_SB(0, 0), b2, voffB); PG8_STAGE(PG8_SB(0, 1), b2 + hstepB, voffB); PG8_STAGE(PG8_SA(0, 0), a2, voffA);
            PG8_WAIT_V(8); PG8_WAIT_L(0); PG8_BAR; PG8_MMA(1, 0, At, B0); PG8_MMA(1, 1, At, B1); PG8_BAR; PG8_SCHED;
            PG8_LDB(B0, 1, 0); PG8_LDB(B1, 1, 1); PG8_SCHED; PG8_LDA(At, 1, 0); PG8_STAGE(PG8_SA(0, 1), a2 + hstepA, voffA);
            PG8_WAIT_V(8); PG8_WAIT_L(0); PG8_BAR; PG8_MMA(0, 0, At, B0); PG8_MMA(0, 1, At, B1); PG8_BAR; PG8_SCHED;
            PG8_LDA(At, 1, 1); PG8_STAGE(PG8_SB(1, 0), b3, voffB); PG8_STAGE(PG8_SB(1, 1), b3 + hstepB, voffB); PG8_STAGE(PG8_SA(1, 0), a3, voffA);
            PG8_WAIT_V(8); PG8_WAIT_L(0); PG8_BAR; PG8_MMA(1, 0, At, B0); PG8_MMA(1, 1, At, B1); PG8_BAR; PG8_SCHED;
        }
        if constexpr (Epi::MID) { if (hf == 0) E.mid(acc, cur, wr, wc, fr, fq); }
        }
        if (wr == 0) PG8_BAR;
        if constexpr (Epi::XCHG) E(acc, cur, wr, wc, fr, fq, lds + STAGE_BYTES, wid, lane); else E(acc, cur, wr, wc, fr, fq);
        if (!has_next) break;
#pragma unroll
        for (int a = 0; a < 2; ++a)
#pragma unroll
            for (int b = 0; b < 2; ++b)
#pragma unroll
                for (int m = 0; m < 4; ++m)
#pragma unroll
                    for (int n = 0; n < 2; ++n) acc[a][b][m][n] = (f32x4){0.f, 0.f, 0.f, 0.f};
        cur = nxt; cA = nA; cB = nB; ++ui;
        if (wr == 1) PG8_BAR;
    }
    PG8_WAIT_V(0);
    PG8_BAR;
#undef PG8_SA
#undef PG8_SB
#undef PG8_STAGE
#undef PG8_LDA
#undef PG8_LDB
#undef PG8_MMA
#undef PG8_WAIT_V
#undef PG8_WAIT_L
#undef PG8_BAR
#undef PG8_SCHED
}
}

struct EpiProj {
    static constexpr bool PERM = true, MID = false, XCHG = false;
    bf16_t* PJ;
    __device__ __forceinline__ void operator()(const f32x4 (&acc)[2][2][4][2], const pg8::Unit& u, int wr, int wc, int fr, int fq) const {
        const int row0 = u.pm * 256 + wr * 64 + fr; const int pn = u.pn;
        const int bidx = u.pm >> 4, t0 = (u.pm & 15) * 256 + wr * 64 + fr;
        if (pn < 8) {
            bf16_t* base = PJ + T_P + 128 * pn + wc * 32 + 8 * fq;
#pragma unroll
            for (int ai = 0; ai < 2; ++ai)
#pragma unroll
                for (int m = 0; m < 4; ++m) {
                    bf16_t* rowp = base + (size_t)(row0 + ai * 128 + m * 16) * 1024;
                    const f32x4 v0 = gelu4(acc[ai][0][m][0]) * silu4(acc[ai][1][m][0]), v1 = gelu4(acc[ai][0][m][1]) * silu4(acc[ai][1][m][1]);
                    u32x4 w; w.x = cvt_pk_bf16(v0[0], v0[1]); w.y = cvt_pk_bf16(v0[2], v0[3]); w.z = cvt_pk_bf16(v1[0], v1[1]); w.w = cvt_pk_bf16(v1[2], v1[3]);
                    __builtin_nontemporal_store(w, (u32x4*)rowp);
                }
        } else {
            int act; size_t dst; int ld, bjs; bool headmajor;
            if (pn < 12) { act = 1; dst = T_GV + 256 * (pn - 8); ld = 1024; bjs = 128; headmajor = false; }
            else if (pn < 14) { act = 4; dst = T_Q + (size_t)(2 * (pn - 12)) * SEQ * 128; ld = 128; bjs = SEQ * 128; headmajor = true; }
            else if (pn < 16) { act = 0; dst = T_K + (size_t)(2 * (pn - 14)) * SEQ * 128; ld = 128; bjs = SEQ * 128; headmajor = true; }
            else if (pn < 20) { act = 0; dst = T_VB + (size_t)(pn - 16) * SEQ * 256; ld = 256; bjs = 128; headmajor = true; }
            else if (pn < 24) { act = 2; dst = T_ZB + (size_t)(pn - 20) * SEQ * 256; ld = 256; bjs = 128; headmajor = true; }
            else { act = 5; dst = T_GA + 128 * (pn - 24); ld = 1024; bjs = (int)(T_GB - T_GA); headmajor = false; }
            const size_t rterm0 = headmajor ? (size_t)bidx * 4 * SEQ + t0 : (size_t)row0;
            bf16_t* base = PJ + dst + wc * 32 + 8 * fq;
#pragma unroll
            for (int ai = 0; ai < 2; ++ai)
#pragma unroll
                for (int m = 0; m < 4; ++m) {
                    bf16_t* rowp = base + (rterm0 + ai * 128 + m * 16) * ld;
#pragma unroll
                    for (int bj = 0; bj < 2; ++bj) {
                        f32x4 v0 = acc[ai][bj][m][0], v1 = acc[ai][bj][m][1];
                        if (act == 5) { v0 = sigm4(v0); v1 = sigm4(v1);
                            if (bj == 0) { const f32x4 b0 = sigm4(acc[ai][1][m][0]), b1 = sigm4(acc[ai][1][m][1]);
#pragma unroll
                                for (int e = 0; e < 4; ++e) { v0[e] *= __builtin_amdgcn_rcpf(fmaxf(b0[e], 1e-20f)); v1[e] *= __builtin_amdgcn_rcpf(fmaxf(b1[e], 1e-20f)); } } }
                        else if (act == 1) { v0 = gelu4(v0); v1 = gelu4(v1); }
                        else if (act == 2) { v0 = silu4(v0); v1 = silu4(v1); }
                        else if (act == 3) { v0 = sigm4(v0); v1 = sigm4(v1); }
                        else if (act == 4) { v0 = v0 * 0.08838834764831845f; v1 = v1 * 0.08838834764831845f; }
                        u32x4 w; w.x = cvt_pk_bf16(v0[0], v0[1]); w.y = cvt_pk_bf16(v0[2], v0[3]); w.z = cvt_pk_bf16(v1[0], v1[1]); w.w = cvt_pk_bf16(v1[2], v1[3]);
                        __builtin_nontemporal_store(w, (u32x4*)(rowp + (size_t)bj * bjs));
                    }
                }
        }
    }
};
struct EpiMerged {
    static constexpr bool PERM = true, MID = true, XCHG = false;
    bf16_t* PJ;
    __device__ __forceinline__ void mid(f32x4 (&acc)[2][2][4][2], const pg8::Unit& u, int wr, int wc, int fr, int fq) const {
        const int row0 = u.pm * 256 + wr * 64 + fr, col0 = u.pn * 256 + wc * 32 + 8 * fq;
        unsigned boff = (unsigned)row0 * 2048u + (unsigned)col0 * 2u; asm volatile("" : "+v"(boff));
#pragma unroll
        for (int ai = 0; ai < 2; ++ai) {
            u32x4 ga[4][2];
#pragma unroll
            for (int m = 0; m < 4; ++m) { const bf16_t* rowp = (const bf16_t*)((const char*)PJ + (size_t)(boff + (unsigned)((ai * 128 + m * 16) * 2048)));
#pragma unroll
                for (int bj = 0; bj < 2; ++bj) ga[m][bj] = *(const u32x4*)(rowp + T_GA + bj * 128); }
            __builtin_amdgcn_sched_barrier(0);
#pragma unroll
            for (int m = 0; m < 4; ++m)
#pragma unroll
                for (int bj = 0; bj < 2; ++bj) {
                    const u32x4 a = ga[m][bj];
                    acc[ai][bj][m][0] = acc[ai][bj][m][0] * (f32x4){bflo(a.x), bfhi(a.x), bflo(a.y), bfhi(a.y)}; acc[ai][bj][m][1] = acc[ai][bj][m][1] * (f32x4){bflo(a.z), bfhi(a.z), bflo(a.w), bfhi(a.w)};
                }
            asm volatile("" ::: "memory");
        }
    }
    __device__ __forceinline__ void operator()(const f32x4 (&acc)[2][2][4][2], const pg8::Unit& u, int wr, int wc, int fr, int fq) const {
        const int row0 = u.pm * 256 + wr * 64 + fr, col0 = u.pn * 256 + wc * 32 + 8 * fq;
        unsigned boff = (unsigned)row0 * 2048u + (unsigned)col0 * 2u; asm volatile("" : "+v"(boff));
#pragma unroll
        for (int ai = 0; ai < 2; ++ai) {
            u32x4 gb[4][2];
#pragma unroll
            for (int m = 0; m < 4; ++m) { const bf16_t* rowp = (const bf16_t*)((const char*)PJ + (size_t)(boff + (unsigned)((ai * 128 + m * 16) * 2048)));
#pragma unroll
                for (int bj = 0; bj < 2; ++bj) gb[m][bj] = *(const u32x4*)(rowp + T_GB + bj * 128); }
            __builtin_amdgcn_sched_barrier(0);
#pragma unroll
            for (int m = 0; m < 4; ++m) { bf16_t* rowp = (bf16_t*)((char*)PJ + (size_t)(boff + (unsigned)((ai * 128 + m * 16) * 2048)));
#pragma unroll
                for (int bj = 0; bj < 2; ++bj) {
                    const u32x4 b = gb[m][bj];
                    const f32x4 v0 = acc[ai][bj][m][0] * (f32x4){bflo(b.x), bfhi(b.x), bflo(b.y), bfhi(b.y)}, v1 = acc[ai][bj][m][1] * (f32x4){bflo(b.z), bfhi(b.z), bflo(b.w), bfhi(b.w)};
                    u32x4 w; w.x = cvt_pk_bf16(v0[0], v0[1]); w.y = cvt_pk_bf16(v0[2], v0[3]); w.z = cvt_pk_bf16(v1[0], v1[1]); w.w = cvt_pk_bf16(v1[2], v1[3]);
                    *(u32x4*)(rowp + T_GV + bj * 128) = w;
                } }
            asm volatile("" ::: "memory");
        }
    }
};
struct EpiOut {
    static constexpr bool PERM = false, MID = false, XCHG = false;
    const float* x; float* out;
    __device__ __forceinline__ void operator()(const f32x4 (&acc)[2][2][4][2], const pg8::Unit& u, int wr, int wc, int fr, int fq) const {
        const int row0 = u.pm * 256 + wr * 64 + fr, col0 = u.pn * 256 + wc * 32 + 4 * fq;
#pragma unroll
        for (int ai = 0; ai < 2; ++ai)
#pragma unroll
            for (int m = 0; m < 4; ++m) {
                const size_t off = (size_t)(row0 + ai * 128 + m * 16) * DM + col0;
#pragma unroll
                for (int bj = 0; bj < 2; ++bj)
#pragma unroll
                    for (int n = 0; n < 2; ++n) { const f32x4 xs = *(const f32x4*)(x + off + bj * 128 + n * 16); *(f32x4*)(out + off + bj * 128 + n * 16) = xs + acc[ai][bj][m][n]; }
            }
    }
};

struct EpiOutNorm {
    static constexpr bool PERM = false, MID = false, XCHG = true;
    const float* x; float* out; const float* gw; unsigned* xbuf; unsigned* cnt;
    __device__ __forceinline__ void operator()(f32x4 (&acc)[2][2][4][2], const pg8::Unit& u, int wr, int wc, int fr, int fq, LAS unsigned char* lds, int wid, int lane) const {
        LAS float* Pt = (LAS float*)lds;
        LAS float* St = (LAS float*)(lds + 4096);
        const int row0 = u.pm * 256 + wr * 64 + fr, col0 = u.pn * 256 + wc * 32 + 4 * fq;
        unsigned boff = (unsigned)row0 * (unsigned)(DM * 4) + (unsigned)col0 * 4u; asm volatile("" : "+v"(boff));
#pragma unroll
        for (int ai = 0; ai < 2; ++ai) {
            f32x4 xv[4][2][2];
#pragma unroll
            for (int m = 0; m < 4; ++m) { const char* xp = (const char*)x + (size_t)(boff + (unsigned)((ai * 128 + m * 16) * DM * 4));
#pragma unroll
                for (int bj = 0; bj < 2; ++bj)
#pragma unroll
                    for (int n = 0; n < 2; ++n) xv[m][bj][n] = *(const f32x4*)(xp + (bj * 128 + n * 16) * 4); }
            __builtin_amdgcn_sched_barrier(0);
#pragma unroll
            for (int m = 0; m < 4; ++m) { float ss = 0.f;
#pragma unroll
                for (int bj = 0; bj < 2; ++bj)
#pragma unroll
                    for (int n = 0; n < 2; ++n) { const f32x4 y = acc[ai][bj][m][n] + xv[m][bj][n]; acc[ai][bj][m][n] = y; ss += (y[0] * y[0] + y[1] * y[1]) + (y[2] * y[2] + y[3] * y[3]); }
                ss += __shfl_xor(ss, 16); ss += __shfl_xor(ss, 32);
                if (fq == 0) Pt[(ai * 128 + wr * 64 + m * 16 + fr) * 4 + wc] = ss; }
            asm volatile("" ::: "memory");
        }
        asm volatile("s_waitcnt lgkmcnt(0)" ::: "memory"); __builtin_amdgcn_s_barrier(); asm volatile("" ::: "memory");
        const int row = wid * 32 + (lane & 31);
        if (lane < 32) { const f32x4 p = *(const LAS f32x4*)(Pt + row * 4);
            __hip_atomic_store(xbuf + ((size_t)(u.pm * 256 + row) * 4 + u.pn), __float_as_uint((p[0] + p[1]) + (p[2] + p[3])), __ATOMIC_RELAXED, __HIP_MEMORY_SCOPE_AGENT); }
        asm volatile("s_waitcnt vmcnt(0)" ::: "memory");
        if (lane == 0) __hip_atomic_fetch_add(cnt + 16 * u.pm, 1u, __ATOMIC_RELAXED, __HIP_MEMORY_SCOPE_AGENT);
        if (wid == 0) { unsigned spins = 0;
            while ((unsigned)__builtin_amdgcn_readfirstlane(__hip_atomic_load(cnt + 16 * u.pm, __ATOMIC_RELAXED, __HIP_MEMORY_SCOPE_AGENT)) < 32u && ++spins < (1u << 22)) __builtin_amdgcn_s_sleep(2);
            __builtin_amdgcn_fence(__ATOMIC_ACQUIRE, "agent"); }
        asm volatile("s_waitcnt vmcnt(0) lgkmcnt(0)" ::: "memory"); __builtin_amdgcn_s_barrier(); asm volatile("" ::: "memory");
        if (lane < 32) { const unsigned* sl = xbuf + (size_t)(u.pm * 256 + row) * 4; float t = 0.f;
#pragma unroll
            for (int k = 0; k < 4; ++k) t += __uint_as_float(__hip_atomic_load(sl + k, __ATOMIC_RELAXED, __HIP_MEMORY_SCOPE_AGENT));
            St[row] = 1.0f / sqrtf(t * (1.0f / DM) + RMS_EPS); }
        asm volatile("s_waitcnt lgkmcnt(0)" ::: "memory"); __builtin_amdgcn_s_barrier(); asm volatile("" ::: "memory");
        f32x4 gv[2][2];
#pragma unroll
        for (int bj = 0; bj < 2; ++bj)
#pragma unroll
            for (int n = 0; n < 2; ++n) gv[bj][n] = *(const f32x4*)(gw + col0 + bj * 128 + n * 16);
#pragma unroll
        for (int ai = 0; ai < 2; ++ai)
#pragma unroll
            for (int m = 0; m < 4; ++m) {
                const float rs = St[ai * 128 + wr * 64 + m * 16 + fr];
                char* op = (char*)out + (size_t)(boff + (unsigned)((ai * 128 + m * 16) * DM * 4));
#pragma unroll
                for (int bj = 0; bj < 2; ++bj)
#pragma unroll
                    for (int n = 0; n < 2; ++n) __builtin_nontemporal_store(acc[ai][bj][m][n] * rs * gv[bj][n], (f32x4*)(op + (bj * 128 + n * 16) * 4));
            }
    }
};

__device__ __forceinline__ void tr_item(const float* W, int ldw, int src_col0, int k0, bf16_t* dst, int ldd, int dst_row0, int dst_col0, LAS float* scr, int lane) {
#pragma unroll 8
    for (int i = 0; i < 32; ++i) { const int kk = 2 * i + (lane >> 5); scr[kk * 33 + (lane & 31)] = W[(size_t)(k0 + kk) * ldw + src_col0 + (lane & 31)]; }
    asm volatile("s_waitcnt lgkmcnt(0)" ::: "memory");
    const int c = lane & 7;
#pragma unroll
    for (int j = 0; j < 4; ++j) { const int n = (lane >> 3) + 8 * j; const LAS float* s = scr + (8 * c) * 33 + n;
        u32x4 o; o.x = pk2(s[0 * 33], s[1 * 33]); o.y = pk2(s[2 * 33], s[3 * 33]); o.z = pk2(s[4 * 33], s[5 * 33]); o.w = pk2(s[6 * 33], s[7 * 33]);
        *(u32x4*)(dst + (size_t)(dst_row0 + n) * ldd + dst_col0 + k0 + 8 * c) = o; }
    asm volatile("s_waitcnt lgkmcnt(0)" ::: "memory");
}
__device__ __forceinline__ void tr_item_regs(const float (&tv)[32], int k0, bf16_t* dst, int ldd, int dst_row0, int dst_col0, LAS float* scr, int lane) {
#pragma unroll
    for (int i = 0; i < 32; ++i) scr[(2 * i + (lane >> 5)) * 33 + (lane & 31)] = tv[i];
    asm volatile("s_waitcnt lgkmcnt(0)" ::: "memory");
    const int c = lane & 7;
#pragma unroll
    for (int j = 0; j < 4; ++j) { const int n = (lane >> 3) + 8 * j; const LAS float* s = scr + (8 * c) * 33 + n;
        u32x4 o; o.x = pk2(s[0 * 33], s[1 * 33]); o.y = pk2(s[2 * 33], s[3 * 33]); o.z = pk2(s[4 * 33], s[5 * 33]); o.w = pk2(s[6 * 33], s[7 * 33]);
        *(u32x4*)(dst + (size_t)(dst_row0 + n) * ldd + dst_col0 + k0 + 8 * c) = o; }
    asm volatile("s_waitcnt lgkmcnt(0)" ::: "memory");
}
__device__ __forceinline__ int win_src_col(int pn, int jb) {
    const int j = 32 * jb;
    if (pn < 8) return j < 128 ? 128 * pn + j : 2048 + 128 * pn + (j - 128);
    if (pn < 12) return 1024 + 256 * (pn - 8) + j;
    if (pn < 14) return 3072 + 256 * (pn - 12) + j;
    if (pn < 16) return 3584 + 256 * (pn - 14) + j;
    if (pn < 20) return 4096 + 256 * (pn - 16) + j;
    if (pn < 24) return 5120 + 256 * (pn - 20) + j;
    return j < 128 ? 6160 + 128 * (pn - 24) + j : 7184 + 128 * (pn - 24) + (j - 128);
}
__device__ __forceinline__ void phase_prologue(const Params& P, LAS unsigned char* lds) {
    const int tid = opaque_tid(), lane = tid & 63, wave = tid >> 6, G = gridDim.x;
    const int gw = blockIdx.x * 8 + wave, NGW = G * 8;
    bf16_t* WinT = (bf16_t*)(P.ws + WS_WINT); bf16_t* WabT = (bf16_t*)(P.ws + WS_WABT); bf16_t* WoT = (bf16_t*)(P.ws + WS_WOT); bf16_t* WsT = (bf16_t*)(P.ws + WS_WST);
    float* LR = (float*)(P.ws + WS_LR); bf16_t* HB = (bf16_t*)P.out;
    LAS float* scr = (LAS float*)(lds + wave * 8704);
    LAS float* Wl = (LAS float*)(lds + 73728);
    for (int i = 0; i < 8; ++i) { const int idx = tid + 512 * i, k = idx >> 2, r4 = idx & 3;
        const f32x4 v = *(const f32x4*)(P.w_in + (size_t)k * NIN + 6144 + 4 * r4);
        Wl[(4 * r4 + 0) * 1024 + k] = v[0]; Wl[(4 * r4 + 1) * 1024 + k] = v[1]; Wl[(4 * r4 + 2) * 1024 + k] = v[2]; Wl[(4 * r4 + 3) * 1024 + k] = v[3]; }
    if (blockIdx.x == 0 && tid < 128) { ((unsigned*)(P.ws + WS_FLAG))[tid * 16] = 0u; ((unsigned*)(P.ws + WS_CNT))[tid * 16] = 0u; if (tid == 0) *(unsigned*)P.ws = 0u; }
    if (blockIdx.x == 0) for (int i = tid; i < 3456; i += 512) ((unsigned*)(P.ws + 16384))[i] = 0u;
    constexpr int I_IN = 16 * 256, I_B = 16 * 32;
    for (int it = gw; it < I_IN; it += 2 * NGW) {
        const int it1 = it + NGW < I_IN ? it + NGW : it; float t0[32], t1[32];
        const int kb0 = it >> 8, d0 = it & 255, c0 = win_src_col(d0 >> 3, d0 & 7), kb1 = it1 >> 8, d1 = it1 & 255, c1 = win_src_col(d1 >> 3, d1 & 7);
#pragma unroll
        for (int i = 0; i < 32; ++i) t0[i] = P.w_in[(size_t)(64 * kb0 + 2 * i + (lane >> 5)) * NIN + c0 + (lane & 31)];
#pragma unroll
        for (int i = 0; i < 32; ++i) t1[i] = P.w_in[(size_t)(64 * kb1 + 2 * i + (lane >> 5)) * NIN + c1 + (lane & 31)];
        tr_item_regs(t0, 64 * kb0, WinT, 1024, 32 * d0, 0, scr, lane);
        if (it1 != it) tr_item_regs(t1, 64 * kb1, WinT, 1024, 32 * d1, 0, scr, lane);
    }
    (void)WabT; (void)WoT; (void)I_B;
    for (int i = blockIdx.x * 512 + tid; i < 8 * 128 * 128 / 4; i += G * 512) {
        const int e = 4 * i, t = (e >> 7) & 127, s = e & 127; const f32x4 v = *(const f32x4*)(P.w_spatial + e);
        u32x2 o; o.x = pk2(s <= t ? v[0] : 0.f, s + 1 <= t ? v[1] : 0.f); o.y = pk2(s + 2 <= t ? v[2] : 0.f, s + 3 <= t ? v[3] : 0.f);
        *(u32x2*)(WsT + e) = o;
    }
    __syncthreads();
    f32x4 ng[4];
#pragma unroll
    for (int j = 0; j < 4; ++j) ng[j] = *(const f32x4*)(P.norm_g + 4 * lane + 256 * j);
    constexpr int RP = 4;
    for (int m0 = gw; m0 < NTOK; m0 += RP * NGW) {
        f32x4 v[RP][4];
#pragma unroll
        for (int q = 0; q < RP; ++q) {
            const f32x4* xr = (const f32x4*)(P.x + (size_t)(m0 + q * NGW) * DM) + lane;
#pragma unroll
            for (int j = 0; j < 4; ++j) v[q][j] = __builtin_nontemporal_load(xr + 64 * j);
        }
#pragma unroll
        for (int q = 0; q < RP; ++q) {
            float ss = 0.f;
#pragma unroll
            for (int j = 0; j < 4; ++j) ss += (v[q][j][0] * v[q][j][0] + v[q][j][1] * v[q][j][1]) + (v[q][j][2] * v[q][j][2] + v[q][j][3] * v[q][j][3]);
            const float rstd = 1.0f / sqrtf(wave_sum(ss) * (1.0f / DM) + RMS_EPS);
            unsigned long long* o8 = (unsigned long long*)(HB + (size_t)(m0 + q * NGW) * DM) + lane;
#pragma unroll
            for (int j = 0; j < 4; ++j) { v[q][j] = v[q][j] * rstd * ng[j]; o8[64 * j] = (unsigned long long)pk2(v[q][j][0], v[q][j][1]) | ((unsigned long long)pk2(v[q][j][2], v[q][j][3]) << 32); }
        }
        float a[RP][16];
#pragma unroll
        for (int r = 0; r < 16; ++r) {
            float sacc[RP];
#pragma unroll
            for (int q = 0; q < RP; ++q) sacc[q] = 0.f;
#pragma unroll
            for (int j = 0; j < 4; ++j) { const f32x4 wv = *(const LAS f32x4*)(Wl + r * 1024 + 4 * lane + 256 * j);
#pragma unroll
                for (int q = 0; q < RP; ++q) sacc[q] += (v[q][j][0] * wv[0] + v[q][j][1] * wv[1]) + (v[q][j][2] * wv[2] + v[q][j][3] * wv[3]); }
            asm volatile("" : "+v"(sacc[0]), "+v"(sacc[1]), "+v"(sacc[2]), "+v"(sacc[3]) :: "memory");
#pragma unroll
            for (int q = 0; q < RP; ++q) a[q][r] = sacc[q];
        }
#pragma unroll
        for (int q = 0; q < RP; ++q) {
            float r8[8], r4[4], r2[2], r1;
            const bool h5 = lane & 32, h4 = lane & 16, h3 = lane & 8, h2 = lane & 4;
#pragma unroll
            for (int i = 0; i < 8; ++i) r8[i] = (h5 ? a[q][i + 8] : a[q][i]) + __shfl_xor(h5 ? a[q][i] : a[q][i + 8], 32);
#pragma unroll
            for (int i = 0; i < 4; ++i) r4[i] = (h4 ? r8[i + 4] : r8[i]) + __shfl_xor(h4 ? r8[i] : r8[i + 4], 16);
#pragma unroll
            for (int i = 0; i < 2; ++i) r2[i] = (h3 ? r4[i + 2] : r4[i]) + __shfl_xor(h3 ? r4[i] : r4[i + 2], 8);
            r1 = (h2 ? r2[1] : r2[0]) + __shfl_xor(h2 ? r2[0] : r2[1], 4);
            r1 += __shfl_xor(r1, 2); r1 += __shfl_xor(r1, 1);
            if ((lane & 3) == 0) LR[(size_t)(m0 + q * NGW) * 16 + (lane >> 2)] = r1;
        }
    }
}

__device__ __forceinline__ void phase_mixer_a(const Params& P, LAS unsigned char* lds, int ustart, int ustride, bool dry) {
    const int tid = opaque_tid(), lane = tid & 63, w = tid >> 6, g4 = lane >> 4, q = (lane & 15) >> 2, p = lane & 3;
    bf16_t* PJ = (bf16_t*)(P.ws + WS_PJ); const bf16_t* WsT = (const bf16_t*)(P.ws + WS_WST);
    constexpr int VN_P = 288, W_P = 272, W_OFF = 128 * VN_P, ST_OFF = W_OFF + 128 * W_P;
    LAS float* stats = (LAS float*)(lds + ST_OFF);
    for (int unit = ustart; unit < NTOK / 128; unit += ustride) {
        const int r0 = unit * 128;
        for (int i0 = 0; i0 < 16; i0 += 4) {
            u32x4 ra[4], rb[4];
#pragma unroll
            for (int q4 = 0; q4 < 4; ++q4) { const u32x4* gp = (const u32x4*)(PJ + T_GV + (size_t)(r0 + 16 * w + i0 + q4) * 1024); ra[q4] = gp[lane]; rb[q4] = gp[lane + 64]; }
#pragma unroll
            for (int q4 = 0; q4 < 4; ++q4) {
                const int s = 16 * w + i0 + q4; const u32x4 a = ra[q4], b = rb[q4];
                float x[16] = {bflo(a.x), bfhi(a.x), bflo(a.y), bfhi(a.y), bflo(a.z), bfhi(a.z), bflo(a.w), bfhi(a.w), bflo(b.x), bfhi(b.x), bflo(b.y), bfhi(b.y), bflo(b.z), bfhi(b.z), bflo(b.w), bfhi(b.w)};
                float sm = 0.f;
#pragma unroll
                for (int j = 0; j < 16; ++j) sm += x[j];
                const float mean = wave_sum(sm) * (1.0f / 1024.0f); float sq = 0.f;
#pragma unroll
                for (int j = 0; j < 16; ++j) { const float d = x[j] - mean; sq += d * d; }
                const float rstd = 1.0f / sqrtf(wave_sum(sq) * (1.0f / 1024.0f) + LN_EPS);
                if (lane == 0) { stats[2 * s] = mean; stats[2 * s + 1] = rstd; }
            }
        }
        __syncthreads();
        u32x4 pgv[4];
#pragma unroll
        for (int i = 0; i < 4; ++i) { const int item = tid + 512 * i, c8 = item & 15, s = item >> 4;
            pgv[i] = *(const u32x4*)(PJ + T_GV + (size_t)(r0 + s) * 1024 + c8 * 8); }
        for (int h = 0; h < 8; ++h) {
#pragma unroll
            for (int i = 0; i < 4; ++i) {
                const int item = tid + 512 * i, c8 = item & 15, s = item >> 4;
                const u32x4 gv = pgv[i];
                const float mean = stats[2 * s], rstd = stats[2 * s + 1];
                const f32x4 g0 = *(const f32x4*)(P.ln_v_g + h * 128 + c8 * 8), g1 = *(const f32x4*)(P.ln_v_g + h * 128 + c8 * 8 + 4);
                const f32x4 b0 = *(const f32x4*)(P.ln_v_b + h * 128 + c8 * 8), b1 = *(const f32x4*)(P.ln_v_b + h * 128 + c8 * 8 + 4);
                u32x4 o;
                o.x = pk2((bflo(gv.x) - mean) * rstd * g0[0] + b0[0], (bfhi(gv.x) - mean) * rstd * g0[1] + b0[1]);
                o.y = pk2((bflo(gv.y) - mean) * rstd * g0[2] + b0[2], (bfhi(gv.y) - mean) * rstd * g0[3] + b0[3]);
                o.z = pk2((bflo(gv.z) - mean) * rstd * g1[0] + b1[0], (bfhi(gv.z) - mean) * rstd * g1[1] + b1[1]);
                o.w = pk2((bflo(gv.w) - mean) * rstd * g1[2] + b1[2], (bfhi(gv.w) - mean) * rstd * g1[3] + b1[3]);
                *(LAS u32x4*)(lds + s * VN_P + c8 * 16) = o;
                *(LAS u32x4*)(lds + W_OFF + s * W_P + c8 * 16) = *(const u32x4*)(WsT + h * 16384 + item * 8);
            }
            __syncthreads();
            if (h + 1 < 8) {
#pragma unroll
                for (int i = 0; i < 4; ++i) { const int item = tid + 512 * i, c8 = item & 15, s = item >> 4;
                    pgv[i] = *(const u32x4*)(PJ + T_GV + (size_t)(r0 + s) * 1024 + (h + 1) * 128 + c8 * 8); }
            }
            u32x2 pv[8]; float bsv[8];
#pragma unroll
            for (int mt = 0; mt < 8; ++mt) { const int t = 16 * mt + (lane & 15);
                pv[mt] = *(const u32x2*)(PJ + T_P + (size_t)(r0 + t) * 1024 + h * 128 + 16 * w + 4 * g4); bsv[mt] = P.b_spatial[h * 128 + t]; }
            f32x4 acc[8];
#pragma unroll
            for (int mt = 0; mt < 8; ++mt) acc[mt] = (f32x4){0.f, 0.f, 0.f, 0.f};
#pragma unroll
            for (int ks = 0; ks < 4; ++ks) {
                const unsigned a0 = (unsigned)((32 * ks + 8 * g4 + q) * VN_P + 32 * w + 8 * p);
                const s16x4 lo = __builtin_amdgcn_ds_read_tr16_b64_v4i16((LAS s16x4*)(lds + a0)), hi = __builtin_amdgcn_ds_read_tr16_b64_v4i16((LAS s16x4*)(lds + a0 + 4 * VN_P));
                const bf16x8 vf = (bf16x8){lo[0], lo[1], lo[2], lo[3], hi[0], hi[1], hi[2], hi[3]};
#pragma unroll
                for (int mt = 2 * ks; mt < 8; ++mt) {
                    const bf16x8 wf = *(const LAS bf16x8*)(lds + W_OFF + (16 * mt + (lane & 15)) * W_P + (32 * ks + 8 * g4) * 2);
                    acc[mt] = __builtin_amdgcn_mfma_f32_16x16x32_bf16(vf, wf, acc[mt], 0, 0, 0);
                }
            }
#pragma unroll
            for (int mt = 0; mt < 8; ++mt) {
                const int t = 16 * mt + (lane & 15); const float bs = bsv[mt];
                u32x2 o; o.x = pk2(bflo(pv[mt].x) * (acc[mt][0] + bs), bfhi(pv[mt].x) * (acc[mt][1] + bs)); o.y = pk2(bflo(pv[mt].y) * (acc[mt][2] + bs), bfhi(pv[mt].y) * (acc[mt][3] + bs));
                if (!dry) *(u32x2*)((bf16_t*)P.out + (size_t)(r0 + t) * 2048 + h * 128 + 16 * w + 4 * g4) = o;
            }
            __syncthreads();
        }
    }
}

__device__ __forceinline__ bf16x8 trfrag(LAS unsigned char* base, int pitch, int row0, int colbyte0, int g, int fr) {
    const unsigned a0 = (unsigned)((row0 + 8 * g + (fr >> 2)) * pitch + colbyte0 + 8 * (fr & 3));
    const s16x4 lo = __builtin_amdgcn_ds_read_tr16_b64_v4i16((LAS s16x4*)(base + a0)), hi = __builtin_amdgcn_ds_read_tr16_b64_v4i16((LAS s16x4*)(base + a0 + 4 * pitch));
    return (bf16x8){lo[0], lo[1], lo[2], lo[3], hi[0], hi[1], hi[2], hi[3]};
}
__device__ __forceinline__ bf16x8 rowfrag(const LAS unsigned char* base, int pitch, int row0, int kbyte0, int g, int fr) {
    return *(const LAS bf16x8*)(base + (row0 + fr) * pitch + kbyte0 + 16 * g);
}

__device__ __forceinline__ void split8(const f32x4 x0, const f32x4 x1, bf16x8& hi, bf16x8& lo) {
#pragma unroll
    for (int j = 0; j < 8; ++j) { const float x = j < 4 ? x0[j & 3] : x1[j & 3]; const unsigned h = f2bf(x); const unsigned l = f2bf(x - bf2f(h)); hi[j] = (short)h; lo[j] = (short)l; }
}
__device__ __forceinline__ void phase_gla_pre(const Params& P, LAS unsigned char* lds, bool dry) {
    const int tid = opaque_tid(), lane = tid & 63, w = tid >> 6, fr = lane & 15, g = lane >> 4;
    bf16_t* PJ = (bf16_t*)(P.ws + WS_PJ); const float* LR = (const float*)(P.ws + WS_LR); float* DEC = (float*)(P.ws + WS_DEC); bf16_t* PB = (bf16_t*)(P.ws + WS_PB);
    constexpr int QP = 272, BP = 528, O_KI = 64 * QP, O_B = 2 * 64 * QP, O_LR = O_B + 64 * BP;
    LAS unsigned char* Lqi = lds; LAS unsigned char* Lki = lds + O_KI; LAS unsigned char* Lb = lds + O_B; LAS float* Llr = (LAS float*)(lds + O_LR);
    const int te = tid >> 3, kc = tid & 7;
    u32x4 rq[2], rk[2]; f32x4 rl = (f32x4){0.f, 0.f, 0.f, 0.f};
    int item = blockIdx.x;
    if (item < 2048) {
        const int bh = item >> 6, row0 = (bh >> 2) * SEQ + (item & 63) * 64; const bf16_t* p_ = PJ + ((size_t)bh * SEQ + (item & 63) * 64 + te) * 128 + 16 * kc;
        rq[0] = *(const u32x4*)(p_ + T_Q); rq[1] = *(const u32x4*)(p_ + T_Q + 8); rk[0] = *(const u32x4*)(p_ + T_K); rk[1] = *(const u32x4*)(p_ + T_K + 8);
        if (tid < 256) rl = *(const f32x4*)(LR + (size_t)row0 * 16 + 4 * tid);
    }
    for (; item < 2048; item += gridDim.x) {
        const int bh = item >> 6, c = item & 63, b = bh >> 2, h = bh & 3, row0 = b * SEQ + c * 64;
        if (tid < 256) *(LAS f32x4*)(Llr + 4 * tid) = rl;
        bf16x8 bhi = (bf16x8){0, 0, 0, 0, 0, 0, 0, 0}, blo = bhi;
        if (g < 2) { f32x4 w0, w1;
#pragma unroll
            for (int j = 0; j < 4; ++j) { w0[j] = P.w_gate_up[(8 * g + j) * 512 + h * 128 + 16 * w + fr]; w1[j] = P.w_gate_up[(8 * g + 4 + j) * 512 + h * 128 + 16 * w + fr]; }
            split8(w0, w1, bhi, blo); }
        const float bg = P.b_gate_up[h * 128 + 16 * w + fr];
        __syncthreads();
        float run = 0.f;
#pragma unroll
        for (int tt = 0; tt < 4; ++tt) {
            bf16x8 ahi = (bf16x8){0, 0, 0, 0, 0, 0, 0, 0}, alo = ahi;
            if (g < 2) { const f32x4 l0 = *(const LAS f32x4*)(Llr + (16 * tt + fr) * 16 + 8 * g), l1 = *(const LAS f32x4*)(Llr + (16 * tt + fr) * 16 + 8 * g + 4); split8(l0, l1, ahi, alo); }
            f32x4 acc = (f32x4){bg, bg, bg, bg};
            acc = __builtin_amdgcn_mfma_f32_16x16x32_bf16(alo, bhi, acc, 0, 0, 0); acc = __builtin_amdgcn_mfma_f32_16x16x32_bf16(ahi, blo, acc, 0, 0, 0); acc = __builtin_amdgcn_mfma_f32_16x16x32_bf16(ahi, bhi, acc, 0, 0, 0);
            float pr[4];
#pragma unroll
            for (int r = 0; r < 4; ++r) { const float lg = acc[r]; const float ls = fminf(lg, 0.f) - __logf(1.0f + __expf(-fabsf(lg))); pr[r] = ls * (1.0f / 16.0f) + (r ? pr[r - 1] : 0.f); }
            const float T = pr[3];
            const float u1 = __shfl_up(T, 16), s1 = T + (g >= 1 ? u1 : 0.f);
            const float u2 = __shfl_up(s1, 32), s2 = s1 + (g >= 2 ? u2 : 0.f);
            const float base = run + (s2 - T); run += __shfl(s2, 48 + fr);
#pragma unroll
            for (int r = 0; r < 4; ++r) *(LAS float*)(Lb + (16 * tt + 4 * g + r) * BP + (16 * w + fr) * 4) = base + pr[r];
        }
        __syncthreads();
        {
            f32x4 bb[4], bm[4], bl[4];
#pragma unroll
            for (int i = 0; i < 4; ++i) { bb[i] = *(const LAS f32x4*)(Lb + te * BP + (16 * kc + 4 * i) * 4); bm[i] = *(const LAS f32x4*)(Lb + 31 * BP + (16 * kc + 4 * i) * 4); bl[i] = *(const LAS f32x4*)(Lb + 63 * BP + (16 * kc + 4 * i) * 4); }
            unsigned oqi[8], oki[8], oqd[8], oks[8];
#pragma unroll
            for (int e2 = 0; e2 < 8; ++e2) {
                const unsigned qw = e2 < 4 ? rq[0][e2] : rq[1][e2 - 4], kw = e2 < 4 ? rk[0][e2] : rk[1][e2 - 4];
                float vqi[2], vki[2], vqd[2], vks[2];
#pragma unroll
                for (int hh = 0; hh < 2; ++hh) {
                    const int e = 2 * e2 + hh; const float bv = bb[e >> 2][e & 3], bmv = bm[e >> 2][e & 3], blv = bl[e >> 2][e & 3];
                    const float qv = hh ? bfhi(qw) : bflo(qw), kv = hh ? bfhi(kw) : bflo(kw);
                    const float e1 = __expf(bv - bmv);
                    vqi[hh] = qv * e1; vki[hh] = kv * __builtin_amdgcn_rcpf(e1); vqd[hh] = qv * __expf(bv); vks[hh] = kv * __expf(blv - bv);
                }
                oqi[e2] = pk2(vqi[0], vqi[1]); oki[e2] = pk2(vki[0], vki[1]); oqd[e2] = pk2(vqd[0], vqd[1]); oks[e2] = pk2(vks[0], vks[1]);
            }
            *(LAS u32x4*)(Lqi + te * QP + 32 * kc) = (u32x4){oqi[0], oqi[1], oqi[2], oqi[3]}; *(LAS u32x4*)(Lqi + te * QP + 32 * kc + 16) = (u32x4){oqi[4], oqi[5], oqi[6], oqi[7]};
            *(LAS u32x4*)(Lki + te * QP + 32 * kc) = (u32x4){oki[0], oki[1], oki[2], oki[3]}; *(LAS u32x4*)(Lki + te * QP + 32 * kc + 16) = (u32x4){oki[4], oki[5], oki[6], oki[7]};
            if (!dry) {
                bf16_t* p_ = PJ + ((size_t)bh * SEQ + c * 64 + te) * 128 + 16 * kc;
                *(u32x4*)(p_ + T_Q) = (u32x4){oqd[0], oqd[1], oqd[2], oqd[3]}; *(u32x4*)(p_ + T_Q + 8) = (u32x4){oqd[4], oqd[5], oqd[6], oqd[7]};
                *(u32x4*)(p_ + T_K) = (u32x4){oks[0], oks[1], oks[2], oks[3]}; *(u32x4*)(p_ + T_K + 8) = (u32x4){oks[4], oks[5], oks[6], oks[7]};
                if (te == 63) {
#pragma unroll
                    for (int i = 0; i < 4; ++i) *(f32x4*)(DEC + (size_t)item * 128 + 16 * kc + 4 * i) = (f32x4){__expf(bl[i][0]), __expf(bl[i][1]), __expf(bl[i][2]), __expf(bl[i][3])};
                }
            }
        }
        { const int ni = item + gridDim.x;
          if (ni < 2048) { const int nbh = ni >> 6, nrow0 = (nbh >> 2) * SEQ + (ni & 63) * 64; const bf16_t* p_ = PJ + ((size_t)nbh * SEQ + (ni & 63) * 64 + te) * 128 + 16 * kc;
            rq[0] = *(const u32x4*)(p_ + T_Q); rq[1] = *(const u32x4*)(p_ + T_Q + 8); rk[0] = *(const u32x4*)(p_ + T_K); rk[1] = *(const u32x4*)(p_ + T_K + 8);
            if (tid < 256) rl = *(const f32x4*)(LR + (size_t)nrow0 * 16 + 4 * tid); } }
        __syncthreads();
        const int tt = w >> 1;
#pragma unroll
        for (int s2i = 0; s2i < 2; ++s2i) {
            const int st = 2 * (w & 1) + s2i; f32x4 acc = (f32x4){0.f, 0.f, 0.f, 0.f};
            if (st <= tt) {
#pragma unroll
                for (int ks = 0; ks < 4; ++ks) acc = __builtin_amdgcn_mfma_f32_16x16x32_bf16(rowfrag(Lki, QP, 16 * st, 64 * ks, g, fr), rowfrag(Lqi, QP, 16 * tt, 64 * ks, g, fr), acc, 0, 0, 0);
            }
            const int t = 16 * tt + fr, sb = 16 * st + 4 * g;
            u32x2 o; o.x = pk2(sb <= t ? acc[0] : 0.f, sb + 1 <= t ? acc[1] : 0.f); o.y = pk2(sb + 2 <= t ? acc[2] : 0.f, sb + 3 <= t ? acc[3] : 0.f);
            if (!dry) *(u32x2*)(PB + (size_t)item * 4096 + t * 64 + sb) = o;
        }
        __syncthreads();
    }
}

namespace gla {
constexpr int KS_P = 288, QD_P = 272, V_P = 544, P_P = 144, ST_P = 272;
constexpr int O_KS = 0, O_QD = O_KS + 64 * KS_P, O_V = O_QD + 64 * QD_P, O_P = O_V + 64 * V_P, O_ST = O_P + 64 * P_P, O_RED = O_ST + 256 * ST_P, O_DEC = O_RED + 2048;
static_assert(O_DEC + 512 <= LDS_BYTES, "GLA scan LDS map");
}
__device__ __forceinline__ void gla_write_st(LAS unsigned char* Lst, const f32x4 (&S)[8][2], int w, int fr, int g) {
#pragma unroll
    for (int kt = 0; kt < 8; ++kt)
#pragma unroll
        for (int vt = 0; vt < 2; ++vt) { u32x2 sv; sv.x = pk2(S[kt][vt][0], S[kt][vt][1]); sv.y = pk2(S[kt][vt][2], S[kt][vt][3]);
            *(LAS u32x2*)(Lst + (32 * w + 16 * vt + fr) * gla::ST_P + (16 * kt + 4 * g) * 2) = sv; }
}
template <bool FULL>
__device__ __forceinline__ void gla_pass(const Params& P, LAS unsigned char* lds, f32x4 (&S)[8][2], int bh, int c0, int L, bool dry) {
    using namespace gla;
    const int tid = opaque_tid(), lane = tid & 63, w = tid >> 6, fr = lane & 15, g = lane >> 4;
    bf16_t* PJ = (bf16_t*)(P.ws + WS_PJ); const float* DEC = (const float*)(P.ws + WS_DEC); const bf16_t* PB = (const bf16_t*)(P.ws + WS_PB);
    LAS unsigned char* Lks = lds + O_KS; LAS unsigned char* Lqd = lds + O_QD; LAS unsigned char* Lv = lds + O_V; LAS unsigned char* Lp = lds + O_P; LAS unsigned char* Lst = lds + O_ST;
    LAS float* red = (LAS float*)(lds + O_RED); LAS float* Ldec = (LAS float*)(lds + O_DEC);
    const int b = bh >> 2, h = bh & 3;
    u32x4 rk[2], rq[2], rv[4], rp; f32x4 rd = (f32x4){0.f, 0.f, 0.f, 0.f};
    const unsigned gk = (unsigned)(tid * 16), gv = (unsigned)(tid * 16);
    const unsigned lk = (unsigned)((tid >> 4) * KS_P + 16 * (tid & 15)), lq = (unsigned)((tid >> 4) * QD_P + 16 * (tid & 15)), lv = (unsigned)((tid >> 5) * V_P + 16 * (tid & 31)), lp = (unsigned)((tid >> 3) * P_P + 16 * (tid & 7));
#define GLA_LOAD(n) do { const char* rbk_ = (const char*)(PJ + T_K + ((size_t)bh * SEQ + (n) * 64) * 128); const char* rbq_ = (const char*)(PJ + T_Q + ((size_t)bh * SEQ + (n) * 64) * 128); \
        const char* rbv_ = (const char*)(PJ + T_VB + ((size_t)bh * SEQ + (n) * 64) * 256); \
        _Pragma("unroll") for (int i = 0; i < 2; ++i) { rk[i] = *(const u32x4*)(rbk_ + (size_t)(gk + (unsigned)(i * 8192))); \
            if (FULL) rq[i] = *(const u32x4*)(rbq_ + (size_t)(gk + (unsigned)(i * 8192))); } \
        _Pragma("unroll") for (int i = 0; i < 4; ++i) rv[i] = *(const u32x4*)(rbv_ + (size_t)(gv + (unsigned)(i * 8192))); \
        if (FULL) rp = *(const u32x4*)(PB + (size_t)(bh * 64 + (n)) * 4096 + tid * 8); \
        if (tid < 32) rd = *(const f32x4*)(DEC + (size_t)(bh * 64 + (n)) * 128 + 4 * tid); } while (0)
#define GLA_STORE() do { \
        _Pragma("unroll") for (int i = 0; i < 2; ++i) { *(LAS u32x4*)(Lks + lk + i * 32 * KS_P) = rk[i]; if (FULL) *(LAS u32x4*)(Lqd + lq + i * 32 * QD_P) = rq[i]; } \
        _Pragma("unroll") for (int i = 0; i < 4; ++i) *(LAS u32x4*)(Lv + lv + i * 16 * V_P) = rv[i]; \
        if (FULL) *(LAS u32x4*)(Lp + lp) = rp; \
        if (tid < 32) *(LAS f32x4*)(Ldec + 4 * tid) = rd; } while (0)
    GLA_LOAD(c0); GLA_STORE();
    __syncthreads();
    for (int n = c0; n < c0 + L; ++n) {
        const size_t row0 = (size_t)(b * SEQ + n * 64);
        if (n + 1 < c0 + L) GLA_LOAD(n + 1);
        u32x2 zb[2][4];
        if (FULL) {
#pragma unroll
            for (int vt = 0; vt < 2; ++vt)
#pragma unroll
                for (int tt = 0; tt < 4; ++tt) zb[vt][tt] = *(const u32x2*)(PJ + T_ZB + ((size_t)bh * SEQ + n * 64 + 16 * tt + fr) * 256 + 32 * w + 16 * vt + 4 * g);
        }
        bf16x8 vf[2][2];
#pragma unroll
        for (int vt = 0; vt < 2; ++vt)
#pragma unroll
            for (int k2 = 0; k2 < 2; ++k2) vf[vt][k2] = trfrag(Lv, V_P, 32 * k2, (32 * w + 16 * vt) * 2, g, fr);
        f32x4 o[2][4];
        if (FULL) {
#pragma unroll
            for (int vt = 0; vt < 2; ++vt)
#pragma unroll
                for (int tt = 0; tt < 4; ++tt) o[vt][tt] = (f32x4){0.f, 0.f, 0.f, 0.f};
#pragma unroll
            for (int k4 = 0; k4 < 4; ++k4) {
                const bf16x8 a0 = rowfrag(Lst, ST_P, 32 * w, 64 * k4, g, fr), a1 = rowfrag(Lst, ST_P, 32 * w + 16, 64 * k4, g, fr);
#pragma unroll
                for (int tt = 0; tt < 4; ++tt) { const bf16x8 bq = rowfrag(Lqd, QD_P, 16 * tt, 64 * k4, g, fr);
                    o[0][tt] = __builtin_amdgcn_mfma_f32_16x16x32_bf16(a0, bq, o[0][tt], 0, 0, 0); o[1][tt] = __builtin_amdgcn_mfma_f32_16x16x32_bf16(a1, bq, o[1][tt], 0, 0, 0); }
            }
#pragma unroll
            for (int k2 = 0; k2 < 2; ++k2)
#pragma unroll
                for (int tt = 0; tt < 4; ++tt) { const bf16x8 bp = rowfrag(Lp, P_P, 16 * tt, 64 * k2, g, fr);
                    o[0][tt] = __builtin_amdgcn_mfma_f32_16x16x32_bf16(vf[0][k2], bp, o[0][tt], 0, 0, 0); o[1][tt] = __builtin_amdgcn_mfma_f32_16x16x32_bf16(vf[1][k2], bp, o[1][tt], 0, 0, 0); }
        }
#pragma unroll
        for (int kt = 0; kt < 8; ++kt) { const f32x4 dv = *(const LAS f32x4*)(Ldec + 16 * kt + 4 * g); S[kt][0] = S[kt][0] * dv; S[kt][1] = S[kt][1] * dv; }
#pragma unroll
        for (int k2 = 0; k2 < 2; ++k2)
#pragma unroll
            for (int kt = 0; kt < 8; ++kt) { const bf16x8 ak = trfrag(Lks, KS_P, 32 * k2, 32 * kt, g, fr);
                S[kt][0] = __builtin_amdgcn_mfma_f32_16x16x32_bf16(ak, vf[0][k2], S[kt][0], 0, 0, 0); S[kt][1] = __builtin_amdgcn_mfma_f32_16x16x32_bf16(ak, vf[1][k2], S[kt][1], 0, 0, 0); }
        if (FULL) {
#pragma unroll
            for (int tt = 0; tt < 4; ++tt) {
                float ss = 0.f;
#pragma unroll
                for (int vt = 0; vt < 2; ++vt) ss += (o[vt][tt][0] * o[vt][tt][0] + o[vt][tt][1] * o[vt][tt][1]) + (o[vt][tt][2] * o[vt][tt][2] + o[vt][tt][3] * o[vt][tt][3]);
                ss += __shfl_xor(ss, 16); ss += __shfl_xor(ss, 32);
                if (g == 0) red[(16 * tt + fr) * 8 + w] = ss;
            }
        }
        __syncthreads();
        if (FULL) gla_write_st(Lst, S, w, fr, g);
        if (n + 1 < c0 + L) GLA_STORE();
        if (FULL) {
            f32x4 gn[2];
#pragma unroll
            for (int vt = 0; vt < 2; ++vt) gn[vt] = *(const f32x4*)(P.gla_norm_g + 32 * w + 4 * g + 16 * vt);
#pragma unroll
            for (int tt = 0; tt < 4; ++tt) {
                const int t = 16 * tt + fr;
                const f32x4 r0 = *(const LAS f32x4*)(red + t * 8), r1 = *(const LAS f32x4*)(red + t * 8 + 4);
                const float rstd = 1.0f / sqrtf(((r0[0] + r0[1]) + (r0[2] + r0[3]) + (r1[0] + r1[1]) + (r1[2] + r1[3])) * (1.0f / 256.0f) + RMS_EPS);
#pragma unroll
                for (int vt = 0; vt < 2; ++vt) {
                    bf16_t* op = (bf16_t*)P.out + (row0 + t) * 2048 + 1024 + h * 256 + 32 * w + 16 * vt + 4 * g;
                    const u32x2 z = zb[vt][tt]; const f32x4 ov = o[vt][tt] * rstd * gn[vt];
                    u32x2 r; r.x = pk2(ov[0] * bflo(z.x), ov[1] * bfhi(z.x)); r.y = pk2(ov[2] * bflo(z.y), ov[3] * bfhi(z.y));
                    if (!dry) *(u32x2*)op = r;
                }
            }
        }
        __syncthreads();
    }
#undef GLA_LOAD
#undef GLA_STORE
}
__device__ __forceinline__ void gla_scan(const Params& P, LAS unsigned char* lds, int bh, int seg, int nseg, bool dry) {
    const int tid = opaque_tid(), lane = tid & 63, w = tid >> 6, fr = lane & 15, g = lane >> 4;
    LAS unsigned char* Lst = lds + gla::O_ST;
    float* SL = (float*)(P.ws + WS_SL); float* DL = (float*)(P.ws + WS_DL); unsigned* FL = (unsigned*)(P.ws + WS_FLAG); const float* DEC = (const float*)(P.ws + WS_DEC);
    const int L = 64 / nseg, c0 = seg * L;
    f32x4 S[8][2];
#pragma unroll
    for (int kt = 0; kt < 8; ++kt) { S[kt][0] = (f32x4){0.f, 0.f, 0.f, 0.f}; S[kt][1] = (f32x4){0.f, 0.f, 0.f, 0.f}; }
    if (seg < nseg - 1) {
        gla_pass<false>(P, lds, S, bh, c0, L, dry);
        char* dst = (char*)(SL + (size_t)(bh * 3 + seg) * 32768);
#pragma unroll
        for (int kt = 0; kt < 8; ++kt)
#pragma unroll
            for (int vt = 0; vt < 2; ++vt) {
                unsigned long long* d8 = (unsigned long long*)(dst + (size_t)((unsigned)tid * 16u + (unsigned)((kt * 2 + vt) * 8192)));
                __hip_atomic_store(d8, (unsigned long long)__float_as_uint(S[kt][vt][0]) | ((unsigned long long)__float_as_uint(S[kt][vt][1]) << 32), __ATOMIC_RELAXED, __HIP_MEMORY_SCOPE_AGENT);
                __hip_atomic_store(d8 + 1, (unsigned long long)__float_as_uint(S[kt][vt][2]) | ((unsigned long long)__float_as_uint(S[kt][vt][3]) << 32), __ATOMIC_RELAXED, __HIP_MEMORY_SCOPE_AGENT); }
        if (tid < 32) {
            f32x4 dc = (f32x4){1.f, 1.f, 1.f, 1.f};
            for (int n = c0; n < c0 + L; ++n) dc = dc * *(const f32x4*)(DEC + (size_t)(bh * 64 + n) * 128 + 4 * tid);
            unsigned long long* d8 = (unsigned long long*)(DL + (size_t)(bh * 4 + seg) * 128 + 4 * tid);
            __hip_atomic_store(d8, (unsigned long long)__float_as_uint(dc[0]) | ((unsigned long long)__float_as_uint(dc[1]) << 32), __ATOMIC_RELAXED, __HIP_MEMORY_SCOPE_AGENT);
            __hip_atomic_store(d8 + 1, (unsigned long long)__float_as_uint(dc[2]) | ((unsigned long long)__float_as_uint(dc[3]) << 32), __ATOMIC_RELAXED, __HIP_MEMORY_SCOPE_AGENT);
        }
        asm volatile("s_waitcnt vmcnt(0)" ::: "memory");
        __syncthreads();
        if (tid == 0) __hip_atomic_store(FL + (bh * 4 + seg) * 16, 1u, __ATOMIC_RELAXED, __HIP_MEMORY_SCOPE_AGENT);
    }
#pragma unroll
    for (int kt = 0; kt < 8; ++kt) { S[kt][0] = (f32x4){0.f, 0.f, 0.f, 0.f}; S[kt][1] = (f32x4){0.f, 0.f, 0.f, 0.f}; }
    if (seg > 0) {
        if (tid == 0) {
            for (int i = 0; i < seg; ++i) { unsigned spins = 0;
                while (__hip_atomic_load(FL + (bh * 4 + i) * 16, __ATOMIC_RELAXED, __HIP_MEMORY_SCOPE_AGENT) == 0u && ++spins < (1u << 22)) __builtin_amdgcn_s_sleep(2); }
            __builtin_amdgcn_fence(__ATOMIC_ACQUIRE, "agent"); asm volatile("s_waitcnt vmcnt(0)" ::: "memory");
        }
        __syncthreads();
        for (int i = 0; i < seg; ++i) {
            const char* src = (const char*)(SL + (size_t)(bh * 3 + i) * 32768); const char* dsrc = (const char*)(DL + (size_t)(bh * 4 + i) * 128);
#pragma unroll
            for (int kt = 0; kt < 8; ++kt) {
                const f32x4 dv = i ? *(const f32x4*)(dsrc + (size_t)((unsigned)g * 16u + (unsigned)(64 * kt))) : (f32x4){0.f, 0.f, 0.f, 0.f};
#pragma unroll
                for (int vt = 0; vt < 2; ++vt) S[kt][vt] = S[kt][vt] * dv + *(const f32x4*)(src + (size_t)((unsigned)tid * 16u + (unsigned)((kt * 2 + vt) * 8192)));
                asm volatile("" : "+v"(S[kt][0]), "+v"(S[kt][1]) :: "memory");
            }
        }
    }
    gla_write_st(Lst, S, w, fr, g);
    gla_pass<true>(P, lds, S, bh, c0, L, dry);
}
__device__ __forceinline__ void phase_branch_weights(const Params& P, LAS unsigned char* lds, int wstart, int wstride) {
    const int tid = opaque_tid(), lane = tid & 63, wave = tid >> 6;
    bf16_t* WabT = (bf16_t*)(P.ws + WS_WABT); bf16_t* WoT = (bf16_t*)(P.ws + WS_WOT);
    LAS float* scr = (LAS float*)(lds + wave * 8704);
    constexpr int I_B = 16 * 32;
    for (int it = wstart * 8 + wave; it < 3 * I_B; it += wstride * 8) {
        int r = it;
        if (r < I_B) { const int kb = r >> 5, nb = r & 31; tr_item(P.w_branch_a, 1024, 32 * nb, 64 * kb, WabT, 2048, 32 * nb, 0, scr, lane); continue; } r -= I_B;
        if (r < I_B) { const int kb = r >> 5, nb = r & 31; tr_item(P.w_branch_b, 1024, 32 * nb, 64 * kb, WabT, 2048, 32 * nb, 1024, scr, lane); continue; } r -= I_B;
        { const int kb = r >> 5, nb = r & 31; tr_item(P.w_out, 1024, 32 * nb, 64 * kb, WoT, 1024, 32 * nb, 0, scr, lane); }
    }
}
__device__ __forceinline__ void phase_scan_and_mixer(const Params& P, LAS unsigned char* lds, bool dry) {
    const int G = gridDim.x, NG = G >= 256 ? 128 : 0;
#if defined(PROBE_SUB)
    if (dry) { if ((int)blockIdx.x < NG) { if (PROBE_SUB == 1) { const int seg = blockIdx.x >> 5, bh = blockIdx.x & 31; gla_scan(P, lds, bh, seg, 4, dry); } } else { if (PROBE_SUB == 2) phase_mixer_a(P, lds, blockIdx.x - NG, G - NG, dry); } return; }
#endif
    if (NG) {
        if ((int)blockIdx.x < NG) { const int seg = blockIdx.x >> 5, bh = blockIdx.x & 31; gla_scan(P, lds, bh, seg, 4, dry); }
        else { phase_mixer_a(P, lds, blockIdx.x - NG, G - NG, dry); phase_branch_weights(P, lds, blockIdx.x - NG, G - NG); }
    } else { for (int bh = blockIdx.x; bh < 32; bh += G) { gla_scan(P, lds, bh, 0, 1, dry); __syncthreads(); } phase_mixer_a(P, lds, blockIdx.x, G, dry); phase_branch_weights(P, lds, blockIdx.x, G); }
}

__device__ __forceinline__ void phase_final_norm(const Params& P, bool dry) {
    const int tid = opaque_tid(), lane = tid & 63, wave = tid >> 6;
    const int gw = blockIdx.x * 8 + wave, NGW = gridDim.x * 8;
    f32x4 ng[4];
#pragma unroll
    for (int j = 0; j < 4; ++j) ng[j] = *(const f32x4*)(P.final_norm_g + 4 * lane + 256 * j);
    for (int m = gw; m < NTOK; m += NGW) {
        f32x4* xr = (f32x4*)(P.out + (size_t)m * DM) + lane;
        f32x4 v[4]; float ss = 0.f;
#pragma unroll
        for (int j = 0; j < 4; ++j) { v[j] = xr[64 * j]; ss += (v[j][0] * v[j][0] + v[j][1] * v[j][1]) + (v[j][2] * v[j][2] + v[j][3] * v[j][3]); }
        const float rstd = 1.0f / sqrtf(wave_sum(ss) * (1.0f / DM) + RMS_EPS);
#pragma unroll
        for (int j = 0; j < 4; ++j) xr[64 * j] = dry ? v[j] : v[j] * rstd * ng[j];
    }
}

template <int PH> __device__ __forceinline__ void run_phase(const Params& P, LAS unsigned char* lds, bool dry) {
    if constexpr (PH == 0) phase_prologue(P, lds);
    if constexpr (PH == 1) { pg8::Gemm g{(const bf16_t*)P.out, (const bf16_t*)(P.ws + WS_WINT), NTOK, 8192, 1024, 1024, 1024}; pg8::StaticOrder S; S.init(NTOK, 8192, gridDim.x, blockIdx.x);
        EpiProj E{(bf16_t*)(P.ws + WS_PJ)}; pg8::gemm_phase<EpiProj>(lds, g, S, E); }
    if constexpr (PH == 2) phase_gla_pre(P, lds, dry);
    if constexpr (PH == 3) phase_scan_and_mixer(P, lds, dry);
    if constexpr (PH == 4) { pg8::Gemm g{(const bf16_t*)P.out, (const bf16_t*)(P.ws + WS_WABT), NTOK, 1024, 2048, 2048, 2048}; pg8::StaticOrder S; S.init(NTOK, 1024, gridDim.x, blockIdx.x);
        EpiMerged E{(bf16_t*)(P.ws + WS_PJ)}; pg8::gemm_phase<EpiMerged>(lds, g, S, E); }
    if constexpr (PH == 5) { pg8::Gemm g{(const bf16_t*)(P.ws + WS_PJ) + T_GV, (const bf16_t*)(P.ws + WS_WOT), NTOK, 1024, 1024, 1024, 1024}; pg8::StaticOrder S; S.init(NTOK, 1024, gridDim.x, blockIdx.x);
        EpiOutNorm E{P.x, P.out, P.final_norm_g, (unsigned*)(P.ws + WS_XB), (unsigned*)(P.ws + WS_CNT)}; pg8::gemm_phase<EpiOutNorm>(lds, g, S, E); }
    if constexpr (PH == 6) phase_final_norm(P, dry);
}

template <int PH> __global__ void __launch_bounds__(512, 2) k_phase(Params P) {
    extern __shared__ __attribute__((aligned(16))) unsigned char shm[];
    run_phase<PH>(P, (LAS unsigned char*)shm, false);
}

__device__ __forceinline__ void grid_barrier(unsigned* ctr, unsigned target) {
    asm volatile("s_waitcnt vmcnt(0)" ::: "memory");
    __syncthreads();
    if (threadIdx.x == 0) {
        __builtin_amdgcn_fence(__ATOMIC_RELEASE, "agent"); asm volatile("s_waitcnt vmcnt(0)" ::: "memory");
        __hip_atomic_fetch_add(ctr, 1u, __ATOMIC_RELAXED, __HIP_MEMORY_SCOPE_AGENT);
        unsigned spins = 0;
        while (__hip_atomic_load(ctr, __ATOMIC_RELAXED, __HIP_MEMORY_SCOPE_AGENT) < target && ++spins < (1u << 24)) __builtin_amdgcn_s_sleep(4);
        __builtin_amdgcn_fence(__ATOMIC_ACQUIRE, "agent"); asm volatile("s_waitcnt vmcnt(0)" ::: "memory");
    }
    __syncthreads();
}
#define XB_TMO      128
#define XB_XCNT(j)  (256  + 64 * (j))
#define XB_XSUB(j)  (1280 + 64 * (j))
#define XB_XGEN(j)  (2304 + 64 * (j))
#define XB_TOP      3328
#define XB_TOPGEN   3392
#define XCD_BAR_WORDS 3456
#define XB_SPIN_CAP (1u << 20)
__device__ __forceinline__ unsigned xb_ld(unsigned* p)              { return __hip_atomic_load(p, __ATOMIC_RELAXED, __HIP_MEMORY_SCOPE_AGENT); }
__device__ __forceinline__ unsigned xb_add(unsigned* p, unsigned v) { return __hip_atomic_fetch_add(p, v, __ATOMIC_RELAXED, __HIP_MEMORY_SCOPE_AGENT); }
__device__ __forceinline__ unsigned xb_xcc_id() { return (unsigned)__builtin_amdgcn_s_getreg((3 << 11) | 20) & 0xFu; }
#define XB_SPIN(cond, bar) do { unsigned _sp = 0; while (cond) { __builtin_amdgcn_s_sleep(1); \
    if ((++_sp & 255u) == 0u) { if (xb_ld(&(bar)[XB_TMO])) break; if (_sp > XB_SPIN_CAP) { atomicAdd(&(bar)[XB_TMO], 1u); break; } } } } while (0)
struct XcdBarrier { unsigned* bar; unsigned x; volatile LAS unsigned* st; };
__device__ __forceinline__ XcdBarrier xcd_barrier_post(unsigned* bar, volatile LAS unsigned* st) {
    XcdBarrier b; b.bar = bar; b.x = xb_xcc_id(); b.st = st;
    if (threadIdx.x == 0) (void)xb_add(&bar[XB_XCNT(b.x)], 1u);
    return b;
}
__device__ __forceinline__ void xcd_barrier_complete(unsigned* bar, unsigned x, unsigned& nloc, unsigned& nx) {
    const unsigned G = gridDim.x * gridDim.y * gridDim.z;
    unsigned sum, cnt, mine, sp = 0u;
    for (;;) {
        sum = 0u; cnt = 0u; mine = 0u;
#pragma unroll
        for (unsigned j = 0; j < 16; ++j) { const unsigned c = xb_ld(&bar[XB_XCNT(j)]); sum += c; cnt += (c > 0u) ? 1u : 0u; mine = (j == x) ? c : mine; }
        if (sum == G) break;
        __builtin_amdgcn_s_sleep(1);
        if ((++sp & 255u) == 0u) { if (xb_ld(&bar[XB_TMO])) break; if (sp > XB_SPIN_CAP) { atomicAdd(&bar[XB_TMO], 1u); break; } }
    }
    nloc = mine > 0u ? mine : 1u; nx = cnt > 0u ? cnt : 1u;
}
__device__ __forceinline__ void xcd_barrier(const XcdBarrier& b) {
    asm volatile("s_waitcnt vmcnt(0)" ::: "memory");
    __syncthreads();
    if (threadIdx.x == 0) {
        unsigned* bar = b.bar;
        __builtin_amdgcn_s_waitcnt(0);
        unsigned nloc = b.st[0], nx = b.st[1];
        if (nloc == 0u) { xcd_barrier_complete(bar, b.x, nloc, nx); b.st[0] = nloc; b.st[1] = nx; }
        const unsigned old = xb_add(&bar[XB_XSUB(b.x)], 1u);
        const unsigned gen = old / nloc;
        if (old + 1u == (gen + 1u) * nloc) {
            __builtin_amdgcn_fence(__ATOMIC_RELEASE, "agent");
            asm volatile("s_waitcnt vmcnt(0)" ::: "memory");
            const unsigned og = xb_add(&bar[XB_TOP], 1u);
            const unsigned tg = og / nx;
            if (og + 1u == (tg + 1u) * nx) xb_add(&bar[XB_TOPGEN], 1u);
            else XB_SPIN(xb_ld(&bar[XB_TOPGEN]) == tg, bar);
            __builtin_amdgcn_fence(__ATOMIC_ACQUIRE, "agent");
            xb_add(&bar[XB_XGEN(b.x)], 1u);
            asm volatile("s_waitcnt vmcnt(0)" ::: "memory");
        } else {
            XB_SPIN(xb_ld(&bar[XB_XGEN(b.x)]) == gen, bar);
            __builtin_amdgcn_fence(__ATOMIC_ACQUIRE, "agent");
            asm volatile("s_waitcnt vmcnt(0)" ::: "memory");
        }
    }
    __syncthreads();
}
constexpr unsigned BAR_MAGIC = 0x600DF00Du;
__device__ __forceinline__ void first_barrier(unsigned* flags  ) {
    asm volatile("s_waitcnt vmcnt(0)" ::: "memory");
    __syncthreads();
    const unsigned G = gridDim.x;
    if (threadIdx.x == 0) {
        __builtin_amdgcn_fence(__ATOMIC_RELEASE, "agent"); asm volatile("s_waitcnt vmcnt(0)" ::: "memory");
        __hip_atomic_store(flags + blockIdx.x, BAR_MAGIC, __ATOMIC_RELAXED, __HIP_MEMORY_SCOPE_AGENT);
    }
    if (blockIdx.x == 0 && threadIdx.x < 64) {
        unsigned spins = 0;
        for (;;) { bool ok = true;
            for (unsigned i = threadIdx.x; i < G; i += 64) ok = ok && (__hip_atomic_load(flags + i, __ATOMIC_RELAXED, __HIP_MEMORY_SCOPE_AGENT) == BAR_MAGIC);
            if (__all(ok) || ++spins > (1u << 22)) break;
            __builtin_amdgcn_s_sleep(1); }
        if (threadIdx.x == 0) __hip_atomic_store(flags + 1024, BAR_MAGIC, __ATOMIC_RELAXED, __HIP_MEMORY_SCOPE_AGENT);
    }
    if (threadIdx.x == 0) {
        unsigned spins = 0;
        while (__hip_atomic_load(flags + 1024, __ATOMIC_RELAXED, __HIP_MEMORY_SCOPE_AGENT) != BAR_MAGIC && ++spins < (1u << 24)) __builtin_amdgcn_s_sleep(1);
        __builtin_amdgcn_fence(__ATOMIC_ACQUIRE, "agent"); asm volatile("s_waitcnt vmcnt(0)" ::: "memory");
    }
    __syncthreads();
}
__device__ __forceinline__ void first_barrier_reset(unsigned* flags) {
    if (threadIdx.x == 0) { flags[blockIdx.x] = 0u; if (blockIdx.x == 0) flags[1024] = 0u; }
}
#if defined(PROBE_MASK)
#define RUN(i) do { if ((PROBE_MASK >> (i)) & 1) { run_phase<i>(P, lds, true); SYNC(); } run_phase<i>(P, lds, false); SYNC(); } while (0)
#else
#define RUN(i) do { run_phase<i>(P, lds, false); SYNC(); } while (0)
#endif
__global__ void __launch_bounds__(512, 2) k_mega(Params P) {
    extern __shared__ __attribute__((aligned(16))) unsigned char shm[];
    LAS unsigned char* lds = (LAS unsigned char*)shm;
    cg::grid_group grid = cg::this_grid();
    unsigned nbar = 0; unsigned* bar = (unsigned*)P.ws;
#define SYNC() xcd_barrier(xb)
    if (P.pad != 0) grid.sync();
    unsigned* fb = (unsigned*)(P.ws + 4096);
    volatile LAS unsigned* xst = (volatile LAS unsigned*)(lds + LDS_BYTES - 16);
    if (threadIdx.x == 0) { xst[0] = 0u; xst[1] = 0u; }
    run_phase<0>(P, lds, false); first_barrier(fb);
    const XcdBarrier xb = xcd_barrier_post((unsigned*)(P.ws + 16384), xst);
    RUN(1); first_barrier_reset(fb); RUN(2); RUN(3); RUN(4);
#if defined(PROBE_MASK)
    if ((PROBE_MASK >> 5) & 1) { run_phase<5>(P, lds, true); SYNC(); }
#endif
    run_phase<5>(P, lds, false);
}

template <class F> static void launch_one(F f, int grid, const Params& p, hipStream_t stream) {
    hipFuncSetAttribute((const void*)f, hipFuncAttributeMaxDynamicSharedMemorySize, LDS_BYTES);
    hipLaunchKernelGGL(f, dim3(grid), dim3(512), LDS_BYTES, stream, p);
}

extern "C" void kernel_launch(void* const* d_in, const int* in_sizes, int n_in, void* d_out, int out_size, void* d_ws, size_t ws_size, hipStream_t stream) {
    if (n_in != 14 || ws_size < WS_END) { fprintf(stderr, "kernel_launch: unexpected n_in %d or ws_size %zu (need %zu)\n", n_in, ws_size, (size_t)WS_END); return; }
    Params p{};
    p.x = (const float*)d_in[0]; p.norm_g = (const float*)d_in[1]; p.w_in = (const float*)d_in[2]; p.ln_v_g = (const float*)d_in[3]; p.ln_v_b = (const float*)d_in[4];
    p.w_spatial = (const float*)d_in[5]; p.b_spatial = (const float*)d_in[6]; p.w_gate_up = (const float*)d_in[7]; p.b_gate_up = (const float*)d_in[8]; p.gla_norm_g = (const float*)d_in[9];
    p.w_branch_a = (const float*)d_in[10]; p.w_branch_b = (const float*)d_in[11]; p.w_out = (const float*)d_in[12]; p.final_norm_g = (const float*)d_in[13];
    p.out = (float*)d_out; p.ws = (unsigned char*)d_ws; p.mask = 0; p.pad = 0;
#if defined(PROBE_MASK)
    p.mask = PROBE_MASK;
#endif
    static int grid = 0;
    if (grid == 0) {
        int dev = 0, cus = 0, per_cu = 0;
        hipGetDevice(&dev); hipDeviceGetAttribute(&cus, hipDeviceAttributeMultiprocessorCount, dev);
        hipFuncSetAttribute((const void*)k_mega, hipFuncAttributeMaxDynamicSharedMemorySize, LDS_BYTES);
        hipOccupancyMaxActiveBlocksPerMultiprocessor(&per_cu, (const void*)k_mega, 512, LDS_BYTES);
        (void)per_cu;
        grid = cus;
    }
#if defined(MULTI_LAUNCH)
    launch_one(k_phase<0>, grid, p, stream); launch_one(k_phase<1>, grid, p, stream); launch_one(k_phase<2>, grid, p, stream); launch_one(k_phase<3>, grid, p, stream);
    launch_one(k_phase<4>, grid, p, stream); launch_one(k_phase<5>, grid, p, stream); launch_one(k_phase<6>, grid, p, stream);
#else
    void* args[] = {&p};
    hipError_t e = hipLaunchCooperativeKernel((void*)k_mega, dim3(grid), dim3(512), args, LDS_BYTES, stream);
    if (e != hipSuccess) fprintf(stderr, "cooperative launch failed: %s (grid %d)\n", hipGetErrorString(e), grid);
#endif
}
```

```cpp
#include <hip/hip_runtime.h>
#include <hip/hip_cooperative_groups.h>
#include <cstdio>
#include <cstdint>
namespace cg = cooperative_groups;

#define LAS __attribute__((address_space(3)))
typedef unsigned short bf16_t;
typedef short bf16x8 __attribute__((ext_vector_type(8)));
typedef short s16x4 __attribute__((ext_vector_type(4)));
typedef float f32x4 __attribute__((ext_vector_type(4)));
typedef float f32x2 __attribute__((ext_vector_type(2)));
typedef unsigned u32x4 __attribute__((ext_vector_type(4)));
typedef unsigned u32x2 __attribute__((ext_vector_type(2)));

constexpr int NTOK = 32768, DM = 1024, SEQ = 4096, NIN = 8208;
constexpr int PJW = 7168;
constexpr int C_A = 0, C_O = 1024, C_GV = 2048, C_Q = 3072, C_K = 3584, C_SZB = 4096, C_GA = 5120, C_GB = 6144;
constexpr size_t T_P = 0, T_GV = (size_t)NTOK * 1024, T_Q = 2 * (size_t)NTOK * 1024, T_K = T_Q + (size_t)NTOK * 512, T_VB = T_K + (size_t)NTOK * 512, T_ZB = T_VB + (size_t)NTOK * 1024, T_GA = T_ZB + (size_t)NTOK * 1024, T_GB = T_GA + (size_t)NTOK * 1024;
constexpr float RMS_EPS = 1e-6f, LN_EPS = 1e-5f;
constexpr size_t MiB = 1u << 20;
constexpr size_t WS_WINT = 1 * MiB, WS_WABT = 17 * MiB, WS_WOT = 21 * MiB, WS_WST = 23 * MiB, WS_LR = 24 * MiB, WS_DEC = 26 * MiB, WS_PJ = 32 * MiB, WS_PB = 480 * MiB, WS_SL = 496 * MiB, WS_END = 508 * MiB;
constexpr size_t WS_XB = 28 * MiB, WS_CNT = 29 * MiB;
constexpr size_t WS_DL = 27 * MiB, WS_FLAG = 27 * MiB + 512 * 1024;
constexpr int LDS_BYTES = 153600;

__device__ __forceinline__ float bf2f(unsigned b) { return __uint_as_float(b << 16); }
__device__ __forceinline__ float bflo(unsigned w) { return __uint_as_float(w << 16); }
__device__ __forceinline__ float bfhi(unsigned w) { return __uint_as_float(w & 0xffff0000u); }
__device__ __forceinline__ unsigned f2bf(float f) { unsigned u = __float_as_uint(f); return (u + 0x7fffu + ((u >> 16) & 1u)) >> 16; }
__device__ __forceinline__ unsigned pk2(float lo, float hi) { return f2bf(lo) | (f2bf(hi) << 16); }
__device__ __forceinline__ unsigned cvt_pk_bf16(float lo, float hi) { unsigned r; asm volatile("v_cvt_pk_bf16_f32 %0, %1, %2" : "=v"(r) : "v"(lo), "v"(hi)); return r; }
__device__ __forceinline__ int opaque_tid() { int t = threadIdx.x; asm volatile("" : "+v"(t)); return t; }
__device__ __forceinline__ float wave_sum(float v) {
#pragma unroll
    for (int o = 1; o < 64; o <<= 1) v += __shfl_xor(v, o);
    return v;
}
__device__ __forceinline__ float sigmoid_f(float x) { return __builtin_amdgcn_rcpf(1.0f + __builtin_amdgcn_exp2f(-1.44269504f * x)); }
__device__ __forceinline__ f32x2 gelu_pk(f32x2 v) {
    const f32x2 av = __builtin_elementwise_abs(v), d = av * 0.2316418882f + 1.0f;
    f32x2 t; t.x = __builtin_amdgcn_rcpf(d.x); t.y = __builtin_amdgcn_rcpf(d.y);
    f32x2 q = t * 0.5307027145f + (-0.7265760135f); q = q * t + 0.7107068705f; q = q * t + (-0.142248368f); q = q * t + 0.127414796f; q = q * t;
    const f32x2 s = (v * v) * (-0.72134752044f);
    f32x2 e; e.x = __builtin_amdgcn_exp2f(s.x); e.y = __builtin_amdgcn_exp2f(s.y);
    const f32x2 m = v * (q * e), r = v - m;
    f32x2 o; o.x = v.x < 0.f ? m.x : r.x; o.y = v.y < 0.f ? m.y : r.y; return o;
}
__device__ __forceinline__ f32x4 gelu4(f32x4 v) { f32x2 a = gelu_pk((f32x2){v[0], v[1]}), b = gelu_pk((f32x2){v[2], v[3]}); return (f32x4){a.x, a.y, b.x, b.y}; }
__device__ __forceinline__ f32x4 sigm4(f32x4 v) { return (f32x4){sigmoid_f(v[0]), sigmoid_f(v[1]), sigmoid_f(v[2]), sigmoid_f(v[3])}; }
__device__ __forceinline__ f32x4 silu4(f32x4 v) { return v * sigm4(v); }

struct Params {
    const float *x, *norm_g, *w_in, *ln_v_g, *ln_v_b, *w_spatial, *b_spatial, *w_gate_up, *b_gate_up, *gla_norm_g, *w_branch_a, *w_branch_b, *w_out, *final_norm_g;
    float* out; unsigned char* ws; int mask; int pad;
};

namespace pg8 {
constexpr int BM = 256, BK = 64, HALF = 128, HTB = HALF * BK * 2, STAGE_BYTES = 8 * HTB, NXCD = 8, WGM = 8;
__host__ __device__ __forceinline__ int lds_byte(int r, int c) { const int st = (r >> 4) * 2 + (c >> 5), rr = r & 15, cc = c & 31, ob = rr * 64 + cc * 2; return st * 1024 + (ob ^ (((ob >> 9) & 1) << 5)); }
__host__ __device__ __forceinline__ void stage_rc(int b, int& R, int& C) { const int st = b / 1024, sb = b % 1024, swz = sb ^ (((sb >> 9) & 1) << 5); R = (st >> 1) * 16 + swz / 64; C = (st & 1) * 32 + (swz % 64) / 2; }
__host__ __device__ __forceinline__ int perm32(int rho) { const int n = rho >> 4, i = rho & 15; return 8 * (i >> 2) + 4 * n + (i & 3); }

struct Unit { int pm, pn; };
struct Gemm { const bf16_t* A; const bf16_t* Bt; int M, N, K, lda, ldb; };

struct StaticOrder {
    int nM, nN, nwg, G, c;
    __host__ __device__ void init(int M, int N, int G_, int c_) { nM = M / BM; nN = N / BM; nwg = nM * nN; G = G_; c = c_; }
    __host__ __device__ bool next(int i, Unit& u) const {
        const long L = (long)i * G + c; if (L >= nwg) return false;
        int wgid = (int)L; { const int q = nwg / NXCD, r = nwg % NXCD, xcd = wgid % NXCD, off = wgid / NXCD; wgid = (xcd < r ? xcd * (q + 1) : r * (q + 1) + (xcd - r) * q) + off; }
        const int nig = WGM * nN, gid = wgid / nig, fm = gid * WGM, gsz = (nM - fm) < WGM ? (nM - fm) : WGM;
        u.pm = fm + ((wgid % nig) % gsz); u.pn = (wgid % nig) / gsz; return true;
    }
};

template <class Epi>
__device__ __forceinline__ void gemm_phase(LAS unsigned char* lds, const Gemm g, const StaticOrder& S, const Epi& E) {
    const int tid = opaque_tid(), wid = __builtin_amdgcn_readfirstlane(tid >> 6), lane = tid & 63, wr = wid >> 2, wc = wid & 3, fr = lane & 15, fq = lane >> 4;
    const int K = g.K, nt = K / BK;
    unsigned voffA[2], voffB[2];
#pragma unroll
    for (int i = 0; i < 2; ++i) { int R, C; stage_rc(tid * 16 + i * 8192, R, C); const int Rb = Epi::PERM ? ((R & ~31) + perm32(R & 31)) : R;
        voffA[i] = (unsigned)(R * g.lda + C) * 2u; voffB[i] = (unsigned)(Rb * g.ldb + C) * 2u; }
    const size_t kstep = (size_t)(BK * 2);
    const size_t hstepA = (size_t)HALF * g.lda * 2, hstepB = (size_t)HALF * g.ldb * 2;
    const size_t tstepA = 2 * hstepA, tstepB = 2 * hstepB;
    const unsigned ldsw = (unsigned)wid * 1024u;
    const int aoff = lds_byte(wr * 64 + fr, fq * 8), boff = lds_byte(wc * 32 + fr, fq * 8);
#define PG8_SA(b, h) (((b) * 2 + (h)) * HTB)
#define PG8_SB(b, h) ((4 + (b) * 2 + (h)) * HTB)
#define PG8_STAGE(bufoff, gbase, voff) do { _Pragma("unroll") for (int _i = 0; _i < 2; ++_i) \
        __builtin_amdgcn_global_load_lds((const unsigned*)((const char*)(gbase) + (voff)[_i]), (LAS unsigned*)(lds + (bufoff) + ldsw + _i * 8192), 16, 0, 0); } while (0)
#define PG8_LDA(dst, b, h) do { _Pragma("unroll") for (int m = 0; m < 4; ++m) _Pragma("unroll") for (int k = 0; k < 2; ++k) dst[m][k] = *(const LAS bf16x8*)(lds + PG8_SA(b, h) + aoff + m * 2048 + k * 1024); } while (0)
#define PG8_LDB(dst, b, h) do { _Pragma("unroll") for (int n = 0; n < 2; ++n) _Pragma("unroll") for (int k = 0; k < 2; ++k) dst[n][k] = *(const LAS bf16x8*)(lds + PG8_SB(b, h) + boff + n * 2048 + k * 1024); } while (0)
#define PG8_MMA(ai, bj, At, Bt) do { __builtin_amdgcn_s_setprio(1); _Pragma("unroll") for (int m = 0; m < 4; ++m) _Pragma("unroll") for (int n = 0; n < 2; ++n) _Pragma("unroll") for (int k = 0; k < 2; ++k) \
        acc[ai][bj][m][n] = __builtin_amdgcn_mfma_f32_16x16x32_bf16(Bt[n][k], At[m][k], acc[ai][bj][m][n], 0, 0, 0); __builtin_amdgcn_s_setprio(0); } while (0)
#define PG8_WAIT_V(n) asm volatile("s_waitcnt vmcnt(" #n ")" ::: "memory")
#define PG8_WAIT_L(n) asm volatile("s_waitcnt lgkmcnt(" #n ")" ::: "memory")
#define PG8_BAR __builtin_amdgcn_s_barrier()
#define PG8_SCHED __builtin_amdgcn_sched_barrier(0)
    Unit cur, nxt; int ui = 0;
    if (!S.next(0, cur)) return;
    f32x4 acc[2][2][4][2];
#pragma unroll
    for (int a = 0; a < 2; ++a)
#pragma unroll
        for (int b = 0; b < 2; ++b)
#pragma unroll
            for (int m = 0; m < 4; ++m)
#pragma unroll
                for (int n = 0; n < 2; ++n) acc[a][b][m][n] = (f32x4){0.f, 0.f, 0.f, 0.f};
    bf16x8 At[4][2], B0[2][2], B1[2][2];
    const char* cA = (const char*)g.A + (size_t)cur.pm * tstepA; const char* cB = (const char*)g.Bt + (size_t)cur.pn * tstepB;
    PG8_STAGE(PG8_SB(0, 0), cB, voffB); PG8_STAGE(PG8_SB(0, 1), cB + hstepB, voffB); PG8_STAGE(PG8_SA(0, 0), cA, voffA); PG8_STAGE(PG8_SA(0, 1), cA + hstepA, voffA);
    if (wr == 1) PG8_BAR;
    PG8_WAIT_V(2); PG8_BAR;
    PG8_STAGE(PG8_SB(1, 0), cB + kstep, voffB); PG8_STAGE(PG8_SA(1, 0), cA + kstep, voffA); PG8_STAGE(PG8_SB(1, 1), cB + hstepB + kstep, voffB);
    PG8_WAIT_V(6); PG8_BAR;
    for (;;) {
        const bool has_next = S.next(ui + 1, nxt);
        const char* nA = has_next ? (const char*)g.A + (size_t)nxt.pm * tstepA : cA; const char* nB = has_next ? (const char*)g.Bt + (size_t)nxt.pn * tstepB : cB;
        const int nh = Epi::MID ? 2 : 1, nth = nt / nh;
        for (int hf = 0; hf < nh; ++hf) {
        for (int t = hf * nth; t < (hf + 1) * nth; t += 2) {
            const bool last = (t == nt - 2);
            const char* a1 = cA + (size_t)(t + 1) * kstep;
            const char* a2 = last ? nA : cA + (size_t)(t + 2) * kstep; const char* b2 = last ? nB : cB + (size_t)(t + 2) * kstep;
            const char* a3 = a2 + kstep; const char* b3 = b2 + kstep;
            PG8_LDB(B0, 0, 0); PG8_LDB(B1, 0, 1); PG8_SCHED; PG8_LDA(At, 0, 0); PG8_STAGE(PG8_SA(1, 1), a1 + hstepA, voffA);
            PG8_WAIT_V(8); PG8_WAIT_L(0); PG8_BAR; PG8_MMA(0, 0, At, B0); PG8_MMA(0, 1, At, B1); PG8_BAR; PG8_SCHED;
            PG8_LDA(At, 0, 1); PG8_STAGE(PG8_SB(0, 0), b2, voffB); PG8_STAGE(PG8_SB(0, 1), b2 + hstepB, voffB); PG8_STAGE(PG8_SA(0, 0), a2, voffA);
            PG8_WAIT_V(8); PG8_WAIT_L(0); PG8_BAR; PG8_MMA(1, 0, At, B0); PG8_MMA(1, 1, At, B1); PG8_BAR; PG8_SCHED;
            PG8_LDB(B0, 1, 0); PG8_LDB(B1, 1, 1); PG8_SCHED; PG8_LDA(At, 1, 0); PG8_STAGE(PG8_SA(0, 1), a2 + hstepA, voffA);
            PG8_WAIT_V(8); PG8_WAIT_L(0); PG8_BAR; PG8_MMA(0, 0, At, B0); PG8_MMA(0, 1, At, B1); PG8_BAR; PG8_SCHED;
            PG8_LDA(At, 1, 1); PG8_STAGE(PG8_SB(1, 0), b3, voffB); PG8_STAGE(PG8_SB(1, 1), b3 + hstepB, voffB); PG8_STAGE(PG8_SA(1, 0), a3, voffA);
            PG8_WAIT_V(8); PG8_WAIT_L(0); PG8_BAR; PG8_MMA(1, 0, At, B0); PG8_MMA(1, 1, At, B1); PG8_BAR; PG8_SCHED;
        }
        if constexpr (Epi::MID) { if (hf == 0) E.mid(acc, cur, wr, wc, fr, fq); }
        }
        if (wr == 0) PG8_BAR;
        if constexpr (Epi::XCHG) E(acc, cur, wr, wc, fr, fq, lds + STAGE_BYTES, wid, lane); else E(acc, cur, wr, wc, fr, fq);
        if (!has_next) break;
#pragma unroll
        for (int a = 0; a < 2; ++a)
#pragma unroll
            for (int b = 0; b < 2; ++b)
#pragma unroll
                for (int m = 0; m < 4; ++m)
#pragma unroll
                    for (int n = 0; n < 2; ++n) acc[a][b][m][n] = (f32x4){0.f, 0.f, 0.f, 0.f};
        cur = nxt; cA = nA; cB = nB; ++ui;
        if (wr == 1) PG8_BAR;
    }
    PG8_WAIT_V(0);
    PG8_BAR;
#undef PG8_SA
#undef PG8_SB
#undef PG8_STAGE
#undef PG8_LDA
#undef PG8_LDB
#undef PG8_MMA
#undef PG8_WAIT_V
#undef PG8_WAIT_L
#undef PG8_BAR
#undef PG8_SCHED
}
}

struct EpiProj {
    static constexpr bool PERM = true, MID = false, XCHG = false;
    bf16_t* PJ;
    __device__ __forceinline__ void operator()(const f32x4 (&acc)[2][2][4][2], const pg8::Unit& u, int wr, int wc, int fr, int fq) const {
        const int row0 = u.pm * 256 + wr * 64 + fr; const int pn = u.pn;
        const int bidx = u.pm >> 4, t0 = (u.pm & 15) * 256 + wr * 64 + fr;
        if (pn < 8) {
            bf16_t* base = PJ + T_P + 128 * pn + wc * 32 + 8 * fq;
#pragma unroll
            for (int ai = 0; ai < 2; ++ai)
#pragma unroll
                for (int m = 0; m < 4; ++m) {
                    bf16_t* rowp = base + (size_t)(row0 + ai * 128 + m * 16) * 1024;
                    const f32x4 v0 = gelu4(acc[ai][0][m][0]) * silu4(acc[ai][1][m][0]), v1 = gelu4(acc[ai][0][m][1]) * silu4(acc[ai][1][m][1]);
                    u32x4 w; w.x = cvt_pk_bf16(v0[0], v0[1]); w.y = cvt_pk_bf16(v0[2], v0[3]); w.z = cvt_pk_bf16(v1[0], v1[1]); w.w = cvt_pk_bf16(v1[2], v1[3]);
                    __builtin_nontemporal_store(w, (u32x4*)rowp);
                }
        } else {
            int act; size_t dst; int ld, bjs; bool headmajor;
            if (pn < 12) { act = 1; dst = T_GV + 256 * (pn - 8); ld = 1024; bjs = 128; headmajor = false; }
            else if (pn < 14) { act = 4; dst = T_Q + (size_t)(2 * (pn - 12)) * SEQ * 128; ld = 128; bjs = SEQ * 128; headmajor = true; }
            else if (pn < 16) { act = 0; dst = T_K + (size_t)(2 * (pn - 14)) * SEQ * 128; ld = 128; bjs = SEQ * 128; headmajor = true; }
            else if (pn < 20) { act = 0; dst = T_VB + (size_t)(pn - 16) * SEQ * 256; ld = 256; bjs = 128; headmajor = true; }
            else if (pn < 24) { act = 2; dst = T_ZB + (size_t)(pn - 20) * SEQ * 256; ld = 256; bjs = 128; headmajor = true; }
            else { act = 5; dst = T_GA + 128 * (pn - 24); ld = 1024; bjs = (int)(T_GB - T_GA); headmajor = false; }
            const size_t rterm0 = headmajor ? (size_t)bidx * 4 * SEQ + t0 : (size_t)row0;
            bf16_t* base = PJ + dst + wc * 32 + 8 * fq;
#pragma unroll
            for (int ai = 0; ai < 2; ++ai)
#pragma unroll
                for (int m = 0; m < 4; ++m) {
                    bf16_t* rowp = base + (rterm0 + ai * 128 + m * 16) * ld;
#pragma unroll
                    for (int bj = 0; bj < 2; ++bj) {
                        f32x4 v0 = acc[ai][bj][m][0], v1 = acc[ai][bj][m][1];
                        if (act == 5) { v0 = sigm4(v0); v1 = sigm4(v1);
                            if (bj == 0) { const f32x4 b0 = sigm4(acc[ai][1][m][0]), b1 = sigm4(acc[ai][1][m][1]);
#pragma unroll
                                for (int e = 0; e < 4; ++e) { v0[e] *= __builtin_amdgcn_rcpf(fmaxf(b0[e], 1e-20f)); v1[e] *= __builtin_amdgcn_rcpf(fmaxf(b1[e], 1e-20f)); } } }
                        else if (act == 1) { v0 = gelu4(v0); v1 = gelu4(v1); }
                        else if (act == 2) { v0 = silu4(v0); v1 = silu4(v1); }
                        else if (act == 3) { v0 = sigm4(v0); v1 = sigm4(v1); }
                        else if (act == 4) { v0 = v0 * 0.08838834764831845f; v1 = v1 * 0.08838834764831845f; }
                        u32x4 w; w.x = cvt_pk_bf16(v0[0], v0[1]); w.y = cvt_pk_bf16(v0[2], v0[3]); w.z = cvt_pk_bf16(v1[0], v1[1]); w.w = cvt_pk_bf16(v1[2], v1[3]);
                        __builtin_nontemporal_store(w, (u32x4*)(rowp + (size_t)bj * bjs));
                    }
                }
        }
    }
};
struct EpiMerged {
    static constexpr bool PERM = true, MID = true, XCHG = false;
    bf16_t* PJ;
    __device__ __forceinline__ void mid(f32x4 (&acc)[2][2][4][2], const pg8::Unit& u, int wr, int wc, int fr, int fq) const {
        const int row0 = u.pm * 256 + wr * 64 + fr, col0 = u.pn * 256 + wc * 32 + 8 * fq;
        unsigned boff = (unsigned)row0 * 2048u + (unsigned)col0 * 2u; asm volatile("" : "+v"(boff));
#pragma unroll
        for (int ai = 0; ai < 2; ++ai) {
            u32x4 ga[4][2];
#pragma unroll
            for (int m = 0; m < 4; ++m) { const bf16_t* rowp = (const bf16_t*)((const char*)PJ + (size_t)(boff + (unsigned)((ai * 128 + m * 16) * 2048)));
#pragma unroll
                for (int bj = 0; bj < 2; ++bj) ga[m][bj] = *(const u32x4*)(rowp + T_GA + bj * 128); }
            __builtin_amdgcn_sched_barrier(0);
#pragma unroll
            for (int m = 0; m < 4; ++m)
#pragma unroll
                for (int bj = 0; bj < 2; ++bj) {
                    const u32x4 a = ga[m][bj];
                    acc[ai][bj][m][0] = acc[ai][bj][m][0] * (f32x4){bflo(a.x), bfhi(a.x), bflo(a.y), bfhi(a.y)}; acc[ai][bj][m][1] = acc[ai][bj][m][1] * (f32x4){bflo(a.z), bfhi(a.z), bflo(a.w), bfhi(a.w)};
                }
            asm volatile("" ::: "memory");
        }
    }
    __device__ __forceinline__ void operator()(const f32x4 (&acc)[2][2][4][2], const pg8::Unit& u, int wr, int wc, int fr, int fq) const {
        const int row0 = u.pm * 256 + wr * 64 + fr, col0 = u.pn * 256 + wc * 32 + 8 * fq;
        unsigned boff = (unsigned)row0 * 2048u + (unsigned)col0 * 2u; asm volatile("" : "+v"(boff));
#pragma unroll
        for (int ai = 0; ai < 2; ++ai) {
            u32x4 gb[4][2];
#pragma unroll
            for (int m = 0; m < 4; ++m) { const bf16_t* rowp = (const bf16_t*)((const char*)PJ + (size_t)(boff + (unsigned)((ai * 128 + m * 16) * 2048)));
#pragma unroll
                for (int bj = 0; bj < 2; ++bj) gb[m][bj] = *(const u32x4*)(rowp + T_GB + bj * 128); }
            __builtin_amdgcn_sched_barrier(0);
#pragma unroll
            for (int m = 0; m < 4; ++m) { bf16_t* rowp = (bf16_t*)((char*)PJ + (size_t)(boff + (unsigned)((ai * 128 + m * 16) * 2048)));
#pragma unroll
                for (int bj = 0; bj < 2; ++bj) {
                    const u32x4 b = gb[m][bj];
                    const f32x4 v0 = acc[ai][bj][m][0] * (f32x4){bflo(b.x), bfhi(b.x), bflo(b.y), bfhi(b.y)}, v1 = acc[ai][bj][m][1] * (f32x4){bflo(b.z), bfhi(b.z), bflo(b.w), bfhi(b.w)};
                    u32x4 w; w.x = cvt_pk_bf16(v0[0], v0[1]); w.y = cvt_pk_bf16(v0[2], v0[3]); w.z = cvt_pk_bf16(v1[0], v1[1]); w.w = cvt_pk_bf16(v1[2], v1[3]);
                    *(u32x4*)(rowp + T_GV + bj * 128) = w;
                } }
            asm volatile("" ::: "memory");
        }
    }
};
struct EpiOut {
    static constexpr bool PERM = false, MID = false, XCHG = false;
    const float* x; float* out;
    __device__ __forceinline__ void operator()(const f32x4 (&acc)[2][2][4][2], const pg8::Unit& u, int wr, int wc, int fr, int fq) const {
        const int row0 = u.pm * 256 + wr * 64 + fr, col0 = u.pn * 256 + wc * 32 + 4 * fq;
#pragma unroll
        for (int ai = 0; ai < 2; ++ai)
#pragma unroll
            for (int m = 0; m < 4; ++m) {
                const size_t off = (size_t)(row0 + ai * 128 + m * 16) * DM + col0;
#pragma unroll
                for (int bj = 0; bj < 2; ++bj)
#pragma unroll
                    for (int n = 0; n < 2; ++n) { const f32x4 xs = *(const f32x4*)(x + off + bj * 128 + n * 16); *(f32x4*)(out + off + bj * 128 + n * 16) = xs + acc[ai][bj][m][n]; }
            }
    }
};

struct EpiOutNorm {
    static constexpr bool PERM = false, MID = false, XCHG = true;
    const float* x; float* out; const float* gw; unsigned* xbuf; unsigned* cnt;
    __device__ __forceinline__ void operator()(f32x4 (&acc)[2][2][4][2], const pg8::Unit& u, int wr, int wc, int fr, int fq, LAS unsigned char* lds, int wid, int lane) const {
        LAS float* Pt = (LAS float*)lds;
        LAS float* St = (LAS float*)(lds + 4096);
        const int row0 = u.pm * 256 + wr * 64 + fr, col0 = u.pn * 256 + wc * 32 + 4 * fq;
        unsigned boff = (unsigned)row0 * (unsigned)(DM * 4) + (unsigned)col0 * 4u; asm volatile("" : "+v"(boff));
#pragma unroll
        for (int ai = 0; ai < 2; ++ai) {
            f32x4 xv[4][2][2];
#pragma unroll
            for (int m = 0; m < 4; ++m) { const char* xp = (const char*)x + (size_t)(boff + (unsigned)((ai * 128 + m * 16) * DM * 4));
#pragma unroll
                for (int bj = 0; bj < 2; ++bj)
#pragma unroll
                    for (int n = 0; n < 2; ++n) xv[m][bj][n] = *(const f32x4*)(xp + (bj * 128 + n * 16) * 4); }
            __builtin_amdgcn_sched_barrier(0);
#pragma unroll
            for (int m = 0; m < 4; ++m) { float ss = 0.f;
#pragma unroll
                for (int bj = 0; bj < 2; ++bj)
#pragma unroll
                    for (int n = 0; n < 2; ++n) { const f32x4 y = acc[ai][bj][m][n] + xv[m][bj][n]; acc[ai][bj][m][n] = y; ss += (y[0] * y[0] + y[1] * y[1]) + (y[2] * y[2] + y[3] * y[3]); }
                ss += __shfl_xor(ss, 16); ss += __shfl_xor(ss, 32);
                if (fq == 0) Pt[(ai * 128 + wr * 64 + m * 16 + fr) * 4 + wc] = ss; }
            asm volatile("" ::: "memory");
        }
        asm volatile("s_waitcnt lgkmcnt(0)" ::: "memory"); __builtin_amdgcn_s_barrier(); asm volatile("" ::: "memory");
        const int row = wid * 32 + (lane & 31);
        if (lane < 32) { const f32x4 p = *(const LAS f32x4*)(Pt + row * 4);
            __hip_atomic_store(xbuf + ((size_t)(u.pm * 256 + row) * 4 + u.pn), __float_as_uint((p[0] + p[1]) + (p[2] + p[3])), __ATOMIC_RELAXED, __HIP_MEMORY_SCOPE_AGENT); }
        asm volatile("s_waitcnt vmcnt(0)" ::: "memory");
        if (lane == 0) __hip_atomic_fetch_add(cnt + 16 * u.pm, 1u, __ATOMIC_RELAXED, __HIP_MEMORY_SCOPE_AGENT);
        if (wid == 0) { unsigned spins = 0;
            while ((unsigned)__builtin_amdgcn_readfirstlane(__hip_atomic_load(cnt + 16 * u.pm, __ATOMIC_RELAXED, __HIP_MEMORY_SCOPE_AGENT)) < 32u && ++spins < (1u << 22)) __builtin_amdgcn_s_sleep(2);
            __builtin_amdgcn_fence(__ATOMIC_ACQUIRE, "agent"); }
        asm volatile("s_waitcnt vmcnt(0) lgkmcnt(0)" ::: "memory"); __builtin_amdgcn_s_barrier(); asm volatile("" ::: "memory");
        if (lane < 32) { const unsigned* sl = xbuf + (size_t)(u.pm * 256 + row) * 4; float t = 0.f;
#pragma unroll
            for (int k = 0; k < 4; ++k) t += __uint_as_float(__hip_atomic_load(sl + k, __ATOMIC_RELAXED, __HIP_MEMORY_SCOPE_AGENT));
            St[row] = 1.0f / sqrtf(t * (1.0f / DM) + RMS_EPS); }
        asm volatile("s_waitcnt lgkmcnt(0)" ::: "memory"); __builtin_amdgcn_s_barrier(); asm volatile("" ::: "memory");
        f32x4 gv[2][2];
#pragma unroll
        for (int bj = 0; bj < 2; ++bj)
#pragma unroll
            for (int n = 0; n < 2; ++n) gv[bj][n] = *(const f32x4*)(gw + col0 + bj * 128 + n * 16);
#pragma unroll
        for (int ai = 0; ai < 2; ++ai)
#pragma unroll
            for (int m = 0; m < 4; ++m) {
                const float rs = St[ai * 128 + wr * 64 + m * 16 + fr];
                char* op = (char*)out + (size_t)(boff + (unsigned)((ai * 128 + m * 16) * DM * 4));
#pragma unroll
                for (int bj = 0; bj < 2; ++bj)
#pragma unroll
                    for (int n = 0; n < 2; ++n) __builtin_nontemporal_store(acc[ai][bj][m][n] * rs * gv[bj][n], (f32x4*)(op + (bj * 128 + n * 16) * 4));
            }
    }
};

__device__ __forceinline__ void tr_item(const float* W, int ldw, int src_col0, int k0, bf16_t* dst, int ldd, int dst_row0, int dst_col0, LAS float* scr, int lane) {
#pragma unroll 8
    for (int i = 0; i < 32; ++i) { const int kk = 2 * i + (lane >> 5); scr[kk * 33 + (lane & 31)] = W[(size_t)(k0 + kk) * ldw + src_col0 + (lane & 31)]; }
    asm volatile("s_waitcnt lgkmcnt(0)" ::: "memory");
    const int c = lane & 7;
#pragma unroll
    for (int j = 0; j < 4; ++j) { const int n = (lane >> 3) + 8 * j; const LAS float* s = scr + (8 * c) * 33 + n;
        u32x4 o; o.x = pk2(s[0 * 33], s[1 * 33]); o.y = pk2(s[2 * 33], s[3 * 33]); o.z = pk2(s[4 * 33], s[5 * 33]); o.w = pk2(s[6 * 33], s[7 * 33]);
        *(u32x4*)(dst + (size_t)(dst_row0 + n) * ldd + dst_col0 + k0 + 8 * c) = o; }
    asm volatile("s_waitcnt lgkmcnt(0)" ::: "memory");
}
__device__ __forceinline__ void tr_item_regs(const float (&tv)[32], int k0, bf16_t* dst, int ldd, int dst_row0, int dst_col0, LAS float* scr, int lane) {
#pragma unroll
    for (int i = 0; i < 32; ++i) scr[(2 * i + (lane >> 5)) * 33 + (lane & 31)] = tv[i];
    asm volatile("s_waitcnt lgkmcnt(0)" ::: "memory");
    const int c = lane & 7;
#pragma unroll
    for (int j = 0; j < 4; ++j) { const int n = (lane >> 3) + 8 * j; const LAS float* s = scr + (8 * c) * 33 + n;
        u32x4 o; o.x = pk2(s[0 * 33], s[1 * 33]); o.y = pk2(s[2 * 33], s[3 * 33]); o.z = pk2(s[4 * 33], s[5 * 33]); o.w = pk2(s[6 * 33], s[7 * 33]);
        *(u32x4*)(dst + (size_t)(dst_row0 + n) * ldd + dst_col0 + k0 + 8 * c) = o; }
    asm volatile("s_waitcnt lgkmcnt(0)" ::: "memory");
}
__device__ __forceinline__ int win_src_col(int pn, int jb) {
    const int j = 32 * jb;
    if (pn < 8) return j < 128 ? 128 * pn + j : 2048 + 128 * pn + (j - 128);
    if (pn < 12) return 1024 + 256 * (pn - 8) + j;
    if (pn < 14) return 3072 + 256 * (pn - 12) + j;
    if (pn < 16) return 3584 + 256 * (pn - 14) + j;
    if (pn < 20) return 4096 + 256 * (pn - 16) + j;
    if (pn < 24) return 5120 + 256 * (pn - 20) + j;
    return j < 128 ? 6160 + 128 * (pn - 24) + j : 7184 + 128 * (pn - 24) + (j - 128);
}
__device__ __forceinline__ void phase_prologue(const Params& P, LAS unsigned char* lds) {
    const int tid = opaque_tid(), lane = tid & 63, wave = tid >> 6, G = gridDim.x;
    const int gw = blockIdx.x * 8 + wave, NGW = G * 8;
    bf16_t* WinT = (bf16_t*)(P.ws + WS_WINT); bf16_t* WabT = (bf16_t*)(P.ws + WS_WABT); bf16_t* WoT = (bf16_t*)(P.ws + WS_WOT); bf16_t* WsT = (bf16_t*)(P.ws + WS_WST);
    float* LR = (float*)(P.ws + WS_LR); bf16_t* HB = (bf16_t*)P.out;
    LAS float* scr = (LAS float*)(lds + wave * 8704);
    LAS float* Wl = (LAS float*)(lds + 73728);
    for (int i = 0; i < 8; ++i) { const int idx = tid + 512 * i, k = idx >> 2, r4 = idx & 3;
        const f32x4 v = *(const f32x4*)(P.w_in + (size_t)k * NIN + 6144 + 4 * r4);
        Wl[(4 * r4 + 0) * 1024 + k] = v[0]; Wl[(4 * r4 + 1) * 1024 + k] = v[1]; Wl[(4 * r4 + 2) * 1024 + k] = v[2]; Wl[(4 * r4 + 3) * 1024 + k] = v[3]; }
    if (blockIdx.x == 0 && tid < 128) { ((unsigned*)(P.ws + WS_FLAG))[tid * 16] = 0u; ((unsigned*)(P.ws + WS_CNT))[tid * 16] = 0u; if (tid == 0) *(unsigned*)P.ws = 0u; }
    if (blockIdx.x == 0) for (int i = tid; i < 3456; i += 512) ((unsigned*)(P.ws + 16384))[i] = 0u;
    constexpr int I_IN = 16 * 256, I_B = 16 * 32;
    for (int it = gw; it < I_IN; it += 2 * NGW) {
        const int it1 = it + NGW < I_IN ? it + NGW : it; float t0[32], t1[32];
        const int kb0 = it >> 8, d0 = it & 255, c0 = win_src_col(d0 >> 3, d0 & 7), kb1 = it1 >> 8, d1 = it1 & 255, c1 = win_src_col(d1 >> 3, d1 & 7);
#pragma unroll
        for (int i = 0; i < 32; ++i) t0[i] = P.w_in[(size_t)(64 * kb0 + 2 * i + (lane >> 5)) * NIN + c0 + (lane & 31)];
#pragma unroll
        for (int i = 0; i < 32; ++i) t1[i] = P.w_in[(size_t)(64 * kb1 + 2 * i + (lane >> 5)) * NIN + c1 + (lane & 31)];
        tr_item_regs(t0, 64 * kb0, WinT, 1024, 32 * d0, 0, scr, lane);
        if (it1 != it) tr_item_regs(t1, 64 * kb1, WinT, 1024, 32 * d1, 0, scr, lane);
    }
    (void)WabT; (void)WoT; (void)I_B;
    for (int i = blockIdx.x * 512 + tid; i < 8 * 128 * 128 / 4; i += G * 512) {
        const int e = 4 * i, t = (e >> 7) & 127, s = e & 127; const f32x4 v = *(const f32x4*)(P.w_spatial + e);
        u32x2 o; o.x = pk2(s <= t ? v[0] : 0.f, s + 1 <= t ? v[1] : 0.f); o.y = pk2(s + 2 <= t ? v[2] : 0.f, s + 3 <= t ? v[3] : 0.f);
        *(u32x2*)(WsT + e) = o;
    }
    __syncthreads();
    f32x4 ng[4];
#pragma unroll
    for (int j = 0; j < 4; ++j) ng[j] = *(const f32x4*)(P.norm_g + 4 * lane + 256 * j);
    constexpr int RP = 4;
    for (int m0 = gw; m0 < NTOK; m0 += RP * NGW) {
        f32x4 v[RP][4];
#pragma unroll
        for (int q = 0; q < RP; ++q) {
            const f32x4* xr = (const f32x4*)(P.x + (size_t)(m0 + q * NGW) * DM) + lane;
#pragma unroll
            for (int j = 0; j < 4; ++j) v[q][j] = __builtin_nontemporal_load(xr + 64 * j);
        }
#pragma unroll
        for (int q = 0; q < RP; ++q) {
            float ss = 0.f;
#pragma unroll
            for (int j = 0; j < 4; ++j) ss += (v[q][j][0] * v[q][j][0] + v[q][j][1] * v[q][j][1]) + (v[q][j][2] * v[q][j][2] + v[q][j][3] * v[q][j][3]);
            const float rstd = 1.0f / sqrtf(wave_sum(ss) * (1.0f / DM) + RMS_EPS);
            unsigned long long* o8 = (unsigned long long*)(HB + (size_t)(m0 + q * NGW) * DM) + lane;
#pragma unroll
            for (int j = 0; j < 4; ++j) { v[q][j] = v[q][j] * rstd * ng[j]; o8[64 * j] = (unsigned long long)pk2(v[q][j][0], v[q][j][1]) | ((unsigned long long)pk2(v[q][j][2], v[q][j][3]) << 32); }
        }
        float a[RP][16];
#pragma unroll
        for (int r = 0; r < 16; ++r) {
            float sacc[RP];
#pragma unroll
            for (int q = 0; q < RP; ++q) sacc[q] = 0.f;
#pragma unroll
            for (int j = 0; j < 4; ++j) { const f32x4 wv = *(const LAS f32x4*)(Wl + r * 1024 + 4 * lane + 256 * j);
#pragma unroll
                for (int q = 0; q < RP; ++q) sacc[q] += (v[q][j][0] * wv[0] + v[q][j][1] * wv[1]) + (v[q][j][2] * wv[2] + v[q][j][3] * wv[3]); }
            asm volatile("" : "+v"(sacc[0]), "+v"(sacc[1]), "+v"(sacc[2]), "+v"(sacc[3]) :: "memory");
#pragma unroll
            for (int q = 0; q < RP; ++q) a[q][r] = sacc[q];
        }
#pragma unroll
        for (int q = 0; q < RP; ++q) {
            float r8[8], r4[4], r2[2], r1;
            const bool h5 = lane & 32, h4 = lane & 16, h3 = lane & 8, h2 = lane & 4;
#pragma unroll
            for (int i = 0; i < 8; ++i) r8[i] = (h5 ? a[q][i + 8] : a[q][i]) + __shfl_xor(h5 ? a[q][i] : a[q][i + 8], 32);
#pragma unroll
            for (int i = 0; i < 4; ++i) r4[i] = (h4 ? r8[i + 4] : r8[i]) + __shfl_xor(h4 ? r8[i] : r8[i + 4], 16);
#pragma unroll
            for (int i = 0; i < 2; ++i) r2[i] = (h3 ? r4[i + 2] : r4[i]) + __shfl_xor(h3 ? r4[i] : r4[i + 2], 8);
            r1 = (h2 ? r2[1] : r2[0]) + __shfl_xor(h2 ? r2[0] : r2[1], 4);
            r1 += __shfl_xor(r1, 2); r1 += __shfl_xor(r1, 1);
            if ((lane & 3) == 0) LR[(size_t)(m0 + q * NGW) * 16 + (lane >> 2)] = r1;
        }
    }
}

__device__ __forceinline__ void phase_mixer_a(const Params& P, LAS unsigned char* lds, int ustart, int ustride, bool dry) {
    const int tid = opaque_tid(), lane = tid & 63, w = tid >> 6, g4 = lane >> 4, q = (lane & 15) >> 2, p = lane & 3;
    bf16_t* PJ = (bf16_t*)(P.ws + WS_PJ); const bf16_t* WsT = (const bf16_t*)(P.ws + WS_WST);
    constexpr int VN_P = 288, W_P = 272, W_OFF = 128 * VN_P, ST_OFF = W_OFF + 128 * W_P;
    LAS float* stats = (LAS float*)(lds + ST_OFF);
    for (int unit = ustart; unit < NTOK / 128; unit += ustride) {
        const int r0 = unit * 128;
        for (int i0 = 0; i0 < 16; i0 += 4) {
            u32x4 ra[4], rb[4];
#pragma unroll
            for (int q4 = 0; q4 < 4; ++q4) { const u32x4* gp = (const u32x4*)(PJ + T_GV + (size_t)(r0 + 16 * w + i0 + q4) * 1024); ra[q4] = gp[lane]; rb[q4] = gp[lane + 64]; }
#pragma unroll
            for (int q4 = 0; q4 < 4; ++q4) {
                const int s = 16 * w + i0 + q4; const u32x4 a = ra[q4], b = rb[q4];
                float x[16] = {bflo(a.x), bfhi(a.x), bflo(a.y), bfhi(a.y), bflo(a.z), bfhi(a.z), bflo(a.w), bfhi(a.w), bflo(b.x), bfhi(b.x), bflo(b.y), bfhi(b.y), bflo(b.z), bfhi(b.z), bflo(b.w), bfhi(b.w)};
                float sm = 0.f;
#pragma unroll
                for (int j = 0; j < 16; ++j) sm += x[j];
                const float mean = wave_sum(sm) * (1.0f / 1024.0f); float sq = 0.f;
#pragma unroll
                for (int j = 0; j < 16; ++j) { const float d = x[j] - mean; sq += d * d; }
                const float rstd = 1.0f / sqrtf(wave_sum(sq) * (1.0f / 1024.0f) + LN_EPS);
                if (lane == 0) { stats[2 * s] = mean; stats[2 * s + 1] = rstd; }
            }
        }
        __syncthreads();
        u32x4 pgv[4];
#pragma unroll
        for (int i = 0; i < 4; ++i) { const int item = tid + 512 * i, c8 = item & 15, s = item >> 4;
            pgv[i] = *(const u32x4*)(PJ + T_GV + (size_t)(r0 + s) * 1024 + c8 * 8); }
        for (int h = 0; h < 8; ++h) {
#pragma unroll
            for (int i = 0; i < 4; ++i) {
                const int item = tid + 512 * i, c8 = item & 15, s = item >> 4;
                const u32x4 gv = pgv[i];
                const float mean = stats[2 * s], rstd = stats[2 * s + 1];
                const f32x4 g0 = *(const f32x4*)(P.ln_v_g + h * 128 + c8 * 8), g1 = *(const f32x4*)(P.ln_v_g + h * 128 + c8 * 8 + 4);
                const f32x4 b0 = *(const f32x4*)(P.ln_v_b + h * 128 + c8 * 8), b1 = *(const f32x4*)(P.ln_v_b + h * 128 + c8 * 8 + 4);
                u32x4 o;
                o.x = pk2((bflo(gv.x) - mean) * rstd * g0[0] + b0[0], (bfhi(gv.x) - mean) * rstd * g0[1] + b0[1]);
                o.y = pk2((bflo(gv.y) - mean) * rstd * g0[2] + b0[2], (bfhi(gv.y) - mean) * rstd * g0[3] + b0[3]);
                o.z = pk2((bflo(gv.z) - mean) * rstd * g1[0] + b1[0], (bfhi(gv.z) - mean) * rstd * g1[1] + b1[1]);
                o.w = pk2((bflo(gv.w) - mean) * rstd * g1[2] + b1[2], (bfhi(gv.w) - mean) * rstd * g1[3] + b1[3]);
                *(LAS u32x4*)(lds + s * VN_P + c8 * 16) = o;
                *(LAS u32x4*)(lds + W_OFF + s * W_P + c8 * 16) = *(const u32x4*)(WsT + h * 16384 + item * 8);
            }
            __syncthreads();
            if (h + 1 < 8) {
#pragma unroll
                for (int i = 0; i < 4; ++i) { const int item = tid + 512 * i, c8 = item & 15, s = item >> 4;
                    pgv[i] = *(const u32x4*)(PJ + T_GV + (size_t)(r0 + s) * 1024 + (h + 1) * 128 + c8 * 8); }
            }
            u32x2 pv[8]; float bsv[8];
#pragma unroll
            for (int mt = 0; mt < 8; ++mt) { const int t = 16 * mt + (lane & 15);
                pv[mt] = *(const u32x2*)(PJ + T_P + (size_t)(r0 + t) * 1024 + h * 128 + 16 * w + 4 * g4); bsv[mt] = P.b_spatial[h * 128 + t]; }
            f32x4 acc[8];
#pragma unroll
            for (int mt = 0; mt < 8; ++mt) acc[mt] = (f32x4){0.f, 0.f, 0.f, 0.f};
#pragma unroll
            for (int ks = 0; ks < 4; ++ks) {
                const unsigned a0 = (unsigned)((32 * ks + 8 * g4 + q) * VN_P + 32 * w + 8 * p);
                const s16x4 lo = __builtin_amdgcn_ds_read_tr16_b64_v4i16((LAS s16x4*)(lds + a0)), hi = __builtin_amdgcn_ds_read_tr16_b64_v4i16((LAS s16x4*)(lds + a0 + 4 * VN_P));
                const bf16x8 vf = (bf16x8){lo[0], lo[1], lo[2], lo[3], hi[0], hi[1], hi[2], hi[3]};
#pragma unroll
                for (int mt = 2 * ks; mt < 8; ++mt) {
                    const bf16x8 wf = *(const LAS bf16x8*)(lds + W_OFF + (16 * mt + (lane & 15)) * W_P + (32 * ks + 8 * g4) * 2);
                    acc[mt] = __builtin_amdgcn_mfma_f32_16x16x32_bf16(vf, wf, acc[mt], 0, 0, 0);
                }
            }
#pragma unroll
            for (int mt = 0; mt < 8; ++mt) {
                const int t = 16 * mt + (lane & 15); const float bs = bsv[mt];
                u32x2 o; o.x = pk2(bflo(pv[mt].x) * (acc[mt][0] + bs), bfhi(pv[mt].x) * (acc[mt][1] + bs)); o.y = pk2(bflo(pv[mt].y) * (acc[mt][2] + bs), bfhi(pv[mt].y) * (acc[mt][3] + bs));
                if (!dry) *(u32x2*)((bf16_t*)P.out + (size_t)(r0 + t) * 2048 + h * 128 + 16 * w + 4 * g4) = o;
            }
            __syncthreads();
        }
    }
}

__device__ __forceinline__ bf16x8 trfrag(LAS unsigned char* base, int pitch, int row0, int colbyte0, int g, int fr) {
    const unsigned a0 = (unsigned)((row0 + 8 * g + (fr >> 2)) * pitch + colbyte0 + 8 * (fr & 3));
    const s16x4 lo = __builtin_amdgcn_ds_read_tr16_b64_v4i16((LAS s16x4*)(base + a0)), hi = __builtin_amdgcn_ds_read_tr16_b64_v4i16((LAS s16x4*)(base + a0 + 4 * pitch));
    return (bf16x8){lo[0], lo[1], lo[2], lo[3], hi[0], hi[1], hi[2], hi[3]};
}
__device__ __forceinline__ bf16x8 rowfrag(const LAS unsigned char* base, int pitch, int row0, int kbyte0, int g, int fr) {
    return *(const LAS bf16x8*)(base + (row0 + fr) * pitch + kbyte0 + 16 * g);
}

__device__ __forceinline__ void split8(const f32x4 x0, const f32x4 x1, bf16x8& hi, bf16x8& lo) {
#pragma unroll
    for (int j = 0; j < 8; ++j) { const float x = j < 4 ? x0[j & 3] : x1[j & 3]; const unsigned h = f2bf(x); const unsigned l = f2bf(x - bf2f(h)); hi[j] = (short)h; lo[j] = (short)l; }
}
__device__ __forceinline__ void phase_gla_pre(const Params& P, LAS unsigned char* lds, bool dry) {
    const int tid = opaque_tid(), lane = tid & 63, w = tid >> 6, fr = lane & 15, g = lane >> 4;
    bf16_t* PJ = (bf16_t*)(P.ws + WS_PJ); const float* LR = (const float*)(P.ws + WS_LR); float* DEC = (float*)(P.ws + WS_DEC); bf16_t* PB = (bf16_t*)(P.ws + WS_PB);
    constexpr int QP = 272, BP = 528, O_KI = 64 * QP, O_B = 2 * 64 * QP, O_LR = O_B + 64 * BP;
    LAS unsigned char* Lqi = lds; LAS unsigned char* Lki = lds + O_KI; LAS unsigned char* Lb = lds + O_B; LAS float* Llr = (LAS float*)(lds + O_LR);
    const int te = tid >> 3, kc = tid & 7;
    u32x4 rq[2], rk[2]; f32x4 rl = (f32x4){0.f, 0.f, 0.f, 0.f};
    int item = blockIdx.x;
    if (item < 2048) {
        const int bh = item >> 6, row0 = (bh >> 2) * SEQ + (item & 63) * 64; const bf16_t* p_ = PJ + ((size_t)bh * SEQ + (item & 63) * 64 + te) * 128 + 16 * kc;
        rq[0] = *(const u32x4*)(p_ + T_Q); rq[1] = *(const u32x4*)(p_ + T_Q + 8); rk[0] = *(const u32x4*)(p_ + T_K); rk[1] = *(const u32x4*)(p_ + T_K + 8);
        if (tid < 256) rl = *(const f32x4*)(LR + (size_t)row0 * 16 + 4 * tid);
    }
    for (; item < 2048; item += gridDim.x) {
        const int bh = item >> 6, c = item & 63, b = bh >> 2, h = bh & 3, row0 = b * SEQ + c * 64;
        if (tid < 256) *(LAS f32x4*)(Llr + 4 * tid) = rl;
        bf16x8 bhi = (bf16x8){0, 0, 0, 0, 0, 0, 0, 0}, blo = bhi;
        if (g < 2) { f32x4 w0, w1;
#pragma unroll
            for (int j = 0; j < 4; ++j) { w0[j] = P.w_gate_up[(8 * g + j) * 512 + h * 128 + 16 * w + fr]; w1[j] = P.w_gate_up[(8 * g + 4 + j) * 512 + h * 128 + 16 * w + fr]; }
            split8(w0, w1, bhi, blo); }
        const float bg = P.b_gate_up[h * 128 + 16 * w + fr];
        __syncthreads();
        float run = 0.f;
#pragma unroll
        for (int tt = 0; tt < 4; ++tt) {
            bf16x8 ahi = (bf16x8){0, 0, 0, 0, 0, 0, 0, 0}, alo = ahi;
            if (g < 2) { const f32x4 l0 = *(const LAS f32x4*)(Llr + (16 * tt + fr) * 16 + 8 * g), l1 = *(const LAS f32x4*)(Llr + (16 * tt + fr) * 16 + 8 * g + 4); split8(l0, l1, ahi, alo); }
            f32x4 acc = (f32x4){bg, bg, bg, bg};
            acc = __builtin_amdgcn_mfma_f32_16x16x32_bf16(alo, bhi, acc, 0, 0, 0); acc = __builtin_amdgcn_mfma_f32_16x16x32_bf16(ahi, blo, acc, 0, 0, 0); acc = __builtin_amdgcn_mfma_f32_16x16x32_bf16(ahi, bhi, acc, 0, 0, 0);
            float pr[4];
#pragma unroll
            for (int r = 0; r < 4; ++r) { const float lg = acc[r]; const float ls = fminf(lg, 0.f) - __logf(1.0f + __expf(-fabsf(lg))); pr[r] = ls * (1.0f / 16.0f) + (r ? pr[r - 1] : 0.f); }
            const float T = pr[3];
            const float u1 = __shfl_up(T, 16), s1 = T + (g >= 1 ? u1 : 0.f);
            const float u2 = __shfl_up(s1, 32), s2 = s1 + (g >= 2 ? u2 : 0.f);
            const float base = run + (s2 - T); run += __shfl(s2, 48 + fr);
#pragma unroll
            for (int r = 0; r < 4; ++r) *(LAS float*)(Lb + (16 * tt + 4 * g + r) * BP + (16 * w + fr) * 4) = base + pr[r];
        }
        __syncthreads();
        {
            f32x4 bb[4], bm[4], bl[4];
#pragma unroll
            for (int i = 0; i < 4; ++i) { bb[i] = *(const LAS f32x4*)(Lb + te * BP + (16 * kc + 4 * i) * 4); bm[i] = *(const LAS f32x4*)(Lb + 31 * BP + (16 * kc + 4 * i) * 4); bl[i] = *(const LAS f32x4*)(Lb + 63 * BP + (16 * kc + 4 * i) * 4); }
            unsigned oqi[8], oki[8], oqd[8], oks[8];
#pragma unroll
            for (int e2 = 0; e2 < 8; ++e2) {
                const unsigned qw = e2 < 4 ? rq[0][e2] : rq[1][e2 - 4], kw = e2 < 4 ? rk[0][e2] : rk[1][e2 - 4];
                float vqi[2], vki[2], vqd[2], vks[2];
#pragma unroll
                for (int hh = 0; hh < 2; ++hh) {
                    const int e = 2 * e2 + hh; const float bv = bb[e >> 2][e & 3], bmv = bm[e >> 2][e & 3], blv = bl[e >> 2][e & 3];
                    const float qv = hh ? bfhi(qw) : bflo(qw), kv = hh ? bfhi(kw) : bflo(kw);
                    const float e1 = __expf(bv - bmv);
                    vqi[hh] = qv * e1; vki[hh] = kv * __builtin_amdgcn_rcpf(e1); vqd[hh] = qv * __expf(bv); vks[hh] = kv * __expf(blv - bv);
                }
                oqi[e2] = pk2(vqi[0], vqi[1]); oki[e2] = pk2(vki[0], vki[1]); oqd[e2] = pk2(vqd[0], vqd[1]); oks[e2] = pk2(vks[0], vks[1]);
            }
            *(LAS u32x4*)(Lqi + te * QP + 32 * kc) = (u32x4){oqi[0], oqi[1], oqi[2], oqi[3]}; *(LAS u32x4*)(Lqi + te * QP + 32 * kc + 16) = (u32x4){oqi[4], oqi[5], oqi[6], oqi[7]};
            *(LAS u32x4*)(Lki + te * QP + 32 * kc) = (u32x4){oki[0], oki[1], oki[2], oki[3]}; *(LAS u32x4*)(Lki + te * QP + 32 * kc + 16) = (u32x4){oki[4], oki[5], oki[6], oki[7]};
            if (!dry) {
                bf16_t* p_ = PJ + ((size_t)bh * SEQ + c * 64 + te) * 128 + 16 * kc;
                *(u32x4*)(p_ + T_Q) = (u32x4){oqd[0], oqd[1], oqd[2], oqd[3]}; *(u32x4*)(p_ + T_Q + 8) = (u32x4){oqd[4], oqd[5], oqd[6], oqd[7]};
                *(u32x4*)(p_ + T_K) = (u32x4){oks[0], oks[1], oks[2], oks[3]}; *(u32x4*)(p_ + T_K + 8) = (u32x4){oks[4], oks[5], oks[6], oks[7]};
                if (te == 63) {
#pragma unroll
                    for (int i = 0; i < 4; ++i) *(f32x4*)(DEC + (size_t)item * 128 + 16 * kc + 4 * i) = (f32x4){__expf(bl[i][0]), __expf(bl[i][1]), __expf(bl[i][2]), __expf(bl[i][3])};
                }
            }
        }
        { const int ni = item + gridDim.x;
          if (ni < 2048) { const int nbh = ni >> 6, nrow0 = (nbh >> 2) * SEQ + (ni & 63) * 64; const bf16_t* p_ = PJ + ((size_t)nbh * SEQ + (ni & 63) * 64 + te) * 128 + 16 * kc;
            rq[0] = *(const u32x4*)(p_ + T_Q); rq[1] = *(const u32x4*)(p_ + T_Q + 8); rk[0] = *(const u32x4*)(p_ + T_K); rk[1] = *(const u32x4*)(p_ + T_K + 8);
            if (tid < 256) rl = *(const f32x4*)(LR + (size_t)nrow0 * 16 + 4 * tid); } }
        __syncthreads();
        const int tt = w >> 1;
#pragma unroll
        for (int s2i = 0; s2i < 2; ++s2i) {
            const int st = 2 * (w & 1) + s2i; f32x4 acc = (f32x4){0.f, 0.f, 0.f, 0.f};
            if (st <= tt) {
#pragma unroll
                for (int ks = 0; ks < 4; ++ks) acc = __builtin_amdgcn_mfma_f32_16x16x32_bf16(rowfrag(Lki, QP, 16 * st, 64 * ks, g, fr), rowfrag(Lqi, QP, 16 * tt, 64 * ks, g, fr), acc, 0, 0, 0);
            }
            const int t = 16 * tt + fr, sb = 16 * st + 4 * g;
            u32x2 o; o.x = pk2(sb <= t ? acc[0] : 0.f, sb + 1 <= t ? acc[1] : 0.f); o.y = pk2(sb + 2 <= t ? acc[2] : 0.f, sb + 3 <= t ? acc[3] : 0.f);
            if (!dry) *(u32x2*)(PB + (size_t)item * 4096 + t * 64 + sb) = o;
        }
        __syncthreads();
    }
}

namespace gla {
constexpr int KS_P = 288, QD_P = 272, V_P = 544, P_P = 144, ST_P = 272;
constexpr int O_KS = 0, O_QD = O_KS + 64 * KS_P, O_V = O_QD + 64 * QD_P, O_P = O_V + 64 * V_P, O_ST = O_P + 64 * P_P, O_RED = O_ST + 256 * ST_P, O_DEC = O_RED + 2048;
static_assert(O_DEC + 512 <= LDS_BYTES, "GLA scan LDS map");
}
__device__ __forceinline__ void gla_write_st(LAS unsigned char* Lst, const f32x4 (&S)[8][2], int w, int fr, int g) {
#pragma unroll
    for (int kt = 0; kt < 8; ++kt)
#pragma unroll
        for (int vt = 0; vt < 2; ++vt) { u32x2 sv; sv.x = pk2(S[kt][vt][0], S[kt][vt][1]); sv.y = pk2(S[kt][vt][2], S[kt][vt][3]);
            *(LAS u32x2*)(Lst + (32 * w + 16 * vt + fr) * gla::ST_P + (16 * kt + 4 * g) * 2) = sv; }
}
template <bool FULL>
__device__ __forceinline__ void gla_pass(const Params& P, LAS unsigned char* lds, f32x4 (&S)[8][2], int bh, int c0, int L, bool dry) {
    using namespace gla;
    const int tid = opaque_tid(), lane = tid & 63, w = tid >> 6, fr = lane & 15, g = lane >> 4;
    bf16_t* PJ = (bf16_t*)(P.ws + WS_PJ); const float* DEC = (const float*)(P.ws + WS_DEC); const bf16_t* PB = (const bf16_t*)(P.ws + WS_PB);
    LAS unsigned char* Lks = lds + O_KS; LAS unsigned char* Lqd = lds + O_QD; LAS unsigned char* Lv = lds + O_V; LAS unsigned char* Lp = lds + O_P; LAS unsigned char* Lst = lds + O_ST;
    LAS float* red = (LAS float*)(lds + O_RED); LAS float* Ldec = (LAS float*)(lds + O_DEC);
    const int b = bh >> 2, h = bh & 3;
    u32x4 rk[2], rq[2], rv[4], rp; f32x4 rd = (f32x4){0.f, 0.f, 0.f, 0.f};
    const unsigned gk = (unsigned)(tid * 16), gv = (unsigned)(tid * 16);
    const unsigned lk = (unsigned)((tid >> 4) * KS_P + 16 * (tid & 15)), lq = (unsigned)((tid >> 4) * QD_P + 16 * (tid & 15)), lv = (unsigned)((tid >> 5) * V_P + 16 * (tid & 31)), lp = (unsigned)((tid >> 3) * P_P + 16 * (tid & 7));
#define GLA_LOAD(n) do { const char* rbk_ = (const char*)(PJ + T_K + ((size_t)bh * SEQ + (n) * 64) * 128); const char* rbq_ = (const char*)(PJ + T_Q + ((size_t)bh * SEQ + (n) * 64) * 128); \
        const char* rbv_ = (const char*)(PJ + T_VB + ((size_t)bh * SEQ + (n) * 64) * 256); \
        _Pragma("unroll") for (int i = 0; i < 2; ++i) { rk[i] = *(const u32x4*)(rbk_ + (size_t)(gk + (unsigned)(i * 8192))); \
            if (FULL) rq[i] = *(const u32x4*)(rbq_ + (size_t)(gk + (unsigned)(i * 8192))); } \
        _Pragma("unroll") for (int i = 0; i < 4; ++i) rv[i] = *(const u32x4*)(rbv_ + (size_t)(gv + (unsigned)(i * 8192))); \
        if (FULL) rp = *(const u32x4*)(PB + (size_t)(bh * 64 + (n)) * 4096 + tid * 8); \
        if (tid < 32) rd = *(const f32x4*)(DEC + (size_t)(bh * 64 + (n)) * 128 + 4 * tid); } while (0)
#define GLA_STORE() do { \
        _Pragma("unroll") for (int i = 0; i < 2; ++i) { *(LAS u32x4*)(Lks + lk + i * 32 * KS_P) = rk[i]; if (FULL) *(LAS u32x4*)(Lqd + lq + i * 32 * QD_P) = rq[i]; } \
        _Pragma("unroll") for (int i = 0; i < 4; ++i) *(LAS u32x4*)(Lv + lv + i * 16 * V_P) = rv[i]; \
        if (FULL) *(LAS u32x4*)(Lp + lp) = rp; \
        if (tid < 32) *(LAS f32x4*)(Ldec + 4 * tid) = rd; } while (0)
    GLA_LOAD(c0); GLA_STORE();
    __syncthreads();
    for (int n = c0; n < c0 + L; ++n) {
        const size_t row0 = (size_t)(b * SEQ + n * 64);
        if (n + 1 < c0 + L) GLA_LOAD(n + 1);
        u32x2 zb[2][4];
        if (FULL) {
#pragma unroll
            for (int vt = 0; vt < 2; ++vt)
#pragma unroll
                for (int tt = 0; tt < 4; ++tt) zb[vt][tt] = *(const u32x2*)(PJ + T_ZB + ((size_t)bh * SEQ + n * 64 + 16 * tt + fr) * 256 + 32 * w + 16 * vt + 4 * g);
        }
        bf16x8 vf[2][2];
#pragma unroll
        for (int vt = 0; vt < 2; ++vt)
#pragma unroll
            for (int k2 = 0; k2 < 2; ++k2) vf[vt][k2] = trfrag(Lv, V_P, 32 * k2, (32 * w + 16 * vt) * 2, g, fr);
        f32x4 o[2][4];
        if (FULL) {
#pragma unroll
            for (int vt = 0; vt < 2; ++vt)
#pragma unroll
                for (int tt = 0; tt < 4; ++tt) o[vt][tt] = (f32x4){0.f, 0.f, 0.f, 0.f};
#pragma unroll
            for (int k4 = 0; k4 < 4; ++k4) {
                const bf16x8 a0 = rowfrag(Lst, ST_P, 32 * w, 64 * k4, g, fr), a1 = rowfrag(Lst, ST_P, 32 * w + 16, 64 * k4, g, fr);
#pragma unroll
                for (int tt = 0; tt < 4; ++tt) { const bf16x8 bq = rowfrag(Lqd, QD_P, 16 * tt, 64 * k4, g, fr);
                    o[0][tt] = __builtin_amdgcn_mfma_f32_16x16x32_bf16(a0, bq, o[0][tt], 0, 0, 0); o[1][tt] = __builtin_amdgcn_mfma_f32_16x16x32_bf16(a1, bq, o[1][tt], 0, 0, 0); }
            }
#pragma unroll
            for (int k2 = 0; k2 < 2; ++k2)
#pragma unroll
                for (int tt = 0; tt < 4; ++tt) { const bf16x8 bp = rowfrag(Lp, P_P, 16 * tt, 64 * k2, g, fr);
                    o[0][tt] = __builtin_amdgcn_mfma_f32_16x16x32_bf16(vf[0][k2], bp, o[0][tt], 0, 0, 0); o[1][tt] = __builtin_amdgcn_mfma_f32_16x16x32_bf16(vf[1][k2], bp, o[1][tt], 0, 0, 0); }
        }
#pragma unroll
        for (int kt = 0; kt < 8; ++kt) { const f32x4 dv = *(const LAS f32x4*)(Ldec + 16 * kt + 4 * g); S[kt][0] = S[kt][0] * dv; S[kt][1] = S[kt][1] * dv; }
#pragma unroll
        for (int k2 = 0; k2 < 2; ++k2)
#pragma unroll
            for (int kt = 0; kt < 8; ++kt) { const bf16x8 ak = trfrag(Lks, KS_P, 32 * k2, 32 * kt, g, fr);
                S[kt][0] = __builtin_amdgcn_mfma_f32_16x16x32_bf16(ak, vf[0][k2], S[kt][0], 0, 0, 0); S[kt][1] = __builtin_amdgcn_mfma_f32_16x16x32_bf16(ak, vf[1][k2], S[kt][1], 0, 0, 0); }
        if (FULL) {
#pragma unroll
            for (int tt = 0; tt < 4; ++tt) {
                float ss = 0.f;
#pragma unroll
                for (int vt = 0; vt < 2; ++vt) ss += (o[vt][tt][0] * o[vt][tt][0] + o[vt][tt][1] * o[vt][tt][1]) + (o[vt][tt][2] * o[vt][tt][2] + o[vt][tt][3] * o[vt][tt][3]);
                ss += __shfl_xor(ss, 16); ss += __shfl_xor(ss, 32);
                if (g == 0) red[(16 * tt + fr) * 8 + w] = ss;
            }
        }
        __syncthreads();
        if (FULL) gla_write_st(Lst, S, w, fr, g);
        if (n + 1 < c0 + L) GLA_STORE();
        if (FULL) {
            f32x4 gn[2];
#pragma unroll
            for (int vt = 0; vt < 2; ++vt) gn[vt] = *(const f32x4*)(P.gla_norm_g + 32 * w + 4 * g + 16 * vt);
#pragma unroll
            for (int tt = 0; tt < 4; ++tt) {
                const int t = 16 * tt + fr;
                const f32x4 r0 = *(const LAS f32x4*)(red + t * 8), r1 = *(const LAS f32x4*)(red + t * 8 + 4);
                const float rstd = 1.0f / sqrtf(((r0[0] + r0[1]) + (r0[2] + r0[3]) + (r1[0] + r1[1]) + (r1[2] + r1[3])) * (1.0f / 256.0f) + RMS_EPS);
#pragma unroll
                for (int vt = 0; vt < 2; ++vt) {
                    bf16_t* op = (bf16_t*)P.out + (row0 + t) * 2048 + 1024 + h * 256 + 32 * w + 16 * vt + 4 * g;
                    const u32x2 z = zb[vt][tt]; const f32x4 ov = o[vt][tt] * rstd * gn[vt];
                    u32x2 r; r.x = pk2(ov[0] * bflo(z.x), ov[1] * bfhi(z.x)); r.y = pk2(ov[2] * bflo(z.y), ov[3] * bfhi(z.y));
                    if (!dry) *(u32x2*)op = r;
                }
            }
        }
        __syncthreads();
    }
#undef GLA_LOAD
#undef GLA_STORE
}
__device__ __forceinline__ void gla_scan(const Params& P, LAS unsigned char* lds, int bh, int seg, int nseg, bool dry) {
    const int tid = opaque_tid(), lane = tid & 63, w = tid >> 6, fr = lane & 15, g = lane >> 4;
    LAS unsigned char* Lst = lds + gla::O_ST;
    float* SL = (float*)(P.ws + WS_SL); float* DL = (float*)(P.ws + WS_DL); unsigned* FL = (unsigned*)(P.ws + WS_FLAG); const float* DEC = (const float*)(P.ws + WS_DEC);
    const int L = 64 / nseg, c0 = seg * L;
    f32x4 S[8][2];
#pragma unroll
    for (int kt = 0; kt < 8; ++kt) { S[kt][0] = (f32x4){0.f, 0.f, 0.f, 0.f}; S[kt][1] = (f32x4){0.f, 0.f, 0.f, 0.f}; }
    if (seg < nseg - 1) {
        gla_pass<false>(P, lds, S, bh, c0, L, dry);
        char* dst = (char*)(SL + (size_t)(bh * 3 + seg) * 32768);
#pragma unroll
        for (int kt = 0; kt < 8; ++kt)
#pragma unroll
            for (int vt = 0; vt < 2; ++vt) *(f32x4*)(dst + (size_t)((unsigned)tid * 16u + (unsigned)((kt * 2 + vt) * 8192))) = S[kt][vt];
        if (tid < 32) {
            f32x4 dc = (f32x4){1.f, 1.f, 1.f, 1.f};
            for (int n = c0; n < c0 + L; ++n) dc = dc * *(const f32x4*)(DEC + (size_t)(bh * 64 + n) * 128 + 4 * tid);
            *(f32x4*)(DL + (size_t)(bh * 4 + seg) * 128 + 4 * tid) = dc;
        }
        asm volatile("s_waitcnt vmcnt(0)" ::: "memory");
        __syncthreads();
        if (tid == 0) { __builtin_amdgcn_fence(__ATOMIC_RELEASE, "agent"); asm volatile("s_waitcnt vmcnt(0)" ::: "memory");
            __hip_atomic_store(FL + (bh * 4 + seg) * 16, 1u, __ATOMIC_RELAXED, __HIP_MEMORY_SCOPE_AGENT); }
    }
#pragma unroll
    for (int kt = 0; kt < 8; ++kt) { S[kt][0] = (f32x4){0.f, 0.f, 0.f, 0.f}; S[kt][1] = (f32x4){0.f, 0.f, 0.f, 0.f}; }
    if (seg > 0) {
        if (tid == 0) {
            for (int i = 0; i < seg; ++i) { unsigned spins = 0;
                while (__hip_atomic_load(FL + (bh * 4 + i) * 16, __ATOMIC_RELAXED, __HIP_MEMORY_SCOPE_AGENT) == 0u && ++spins < (1u << 22)) __builtin_amdgcn_s_sleep(2); }
            __builtin_amdgcn_fence(__ATOMIC_ACQUIRE, "agent"); asm volatile("s_waitcnt vmcnt(0)" ::: "memory");
        }
        __syncthreads();
        for (int i = 0; i < seg; ++i) {
            const char* src = (const char*)(SL + (size_t)(bh * 3 + i) * 32768); const char* dsrc = (const char*)(DL + (size_t)(bh * 4 + i) * 128);
#pragma unroll
            for (int kt = 0; kt < 8; ++kt) {
                const f32x4 dv = i ? *(const f32x4*)(dsrc + (size_t)((unsigned)g * 16u + (unsigned)(64 * kt))) : (f32x4){0.f, 0.f, 0.f, 0.f};
#pragma unroll
                for (int vt = 0; vt < 2; ++vt) S[kt][vt] = S[kt][vt] * dv + *(const f32x4*)(src + (size_t)((unsigned)tid * 16u + (unsigned)((kt * 2 + vt) * 8192)));
                asm volatile("" : "+v"(S[kt][0]), "+v"(S[kt][1]) :: "memory");
            }
        }
    }
    gla_write_st(Lst, S, w, fr, g);
    gla_pass<true>(P, lds, S, bh, c0, L, dry);
}
__device__ __forceinline__ void phase_branch_weights(const Params& P, LAS unsigned char* lds, int wstart, int wstride) {
    const int tid = opaque_tid(), lane = tid & 63, wave = tid >> 6;
    bf16_t* WabT = (bf16_t*)(P.ws + WS_WABT); bf16_t* WoT = (bf16_t*)(P.ws + WS_WOT);
    LAS float* scr = (LAS float*)(lds + wave * 8704);
    constexpr int I_B = 16 * 32;
    for (int it = wstart * 8 + wave; it < 3 * I_B; it += wstride * 8) {
        int r = it;
        if (r < I_B) { const int kb = r >> 5, nb = r & 31; tr_item(P.w_branch_a, 1024, 32 * nb, 64 * kb, WabT, 2048, 32 * nb, 0, scr, lane); continue; } r -= I_B;
        if (r < I_B) { const int kb = r >> 5, nb = r & 31; tr_item(P.w_branch_b, 1024, 32 * nb, 64 * kb, WabT, 2048, 32 * nb, 1024, scr, lane); continue; } r -= I_B;
        { const int kb = r >> 5, nb = r & 31; tr_item(P.w_out, 1024, 32 * nb, 64 * kb, WoT, 1024, 32 * nb, 0, scr, lane); }
    }
}
__device__ __forceinline__ void phase_scan_and_mixer(const Params& P, LAS unsigned char* lds, bool dry) {
    const int G = gridDim.x, NG = G >= 256 ? 128 : 0;
#if defined(PROBE_SUB)
    if (dry) { if ((int)blockIdx.x < NG) { if (PROBE_SUB == 1) { const int seg = blockIdx.x >> 5, bh = blockIdx.x & 31; gla_scan(P, lds, bh, seg, 4, dry); } } else { if (PROBE_SUB == 2) phase_mixer_a(P, lds, blockIdx.x - NG, G - NG, dry); } return; }
#endif
    if (NG) {
        if ((int)blockIdx.x < NG) { const int seg = blockIdx.x >> 5, bh = blockIdx.x & 31; gla_scan(P, lds, bh, seg, 4, dry); }
        else { phase_branch_weights(P, lds, blockIdx.x - NG, G - NG); __syncthreads(); phase_mixer_a(P, lds, blockIdx.x - NG, G - NG, dry); }
    } else { for (int bh = blockIdx.x; bh < 32; bh += G) { gla_scan(P, lds, bh, 0, 1, dry); __syncthreads(); } phase_mixer_a(P, lds, blockIdx.x, G, dry); phase_branch_weights(P, lds, blockIdx.x, G); }
}

__device__ __forceinline__ void phase_final_norm(const Params& P, bool dry) {
    const int tid = opaque_tid(), lane = tid & 63, wave = tid >> 6;
    const int gw = blockIdx.x * 8 + wave, NGW = gridDim.x * 8;
    f32x4 ng[4];
#pragma unroll
    for (int j = 0; j < 4; ++j) ng[j] = *(const f32x4*)(P.final_norm_g + 4 * lane + 256 * j);
    for (int m = gw; m < NTOK; m += NGW) {
        f32x4* xr = (f32x4*)(P.out + (size_t)m * DM) + lane;
        f32x4 v[4]; float ss = 0.f;
#pragma unroll
        for (int j = 0; j < 4; ++j) { v[j] = xr[64 * j]; ss += (v[j][0] * v[j][0] + v[j][1] * v[j][1]) + (v[j][2] * v[j][2] + v[j][3] * v[j][3]); }
        const float rstd = 1.0f / sqrtf(wave_sum(ss) * (1.0f / DM) + RMS_EPS);
#pragma unroll
        for (int j = 0; j < 4; ++j) xr[64 * j] = dry ? v[j] : v[j] * rstd * ng[j];
    }
}

template <int PH> __device__ __forceinline__ void run_phase(const Params& P, LAS unsigned char* lds, bool dry) {
    if constexpr (PH == 0) phase_prologue(P, lds);
    if constexpr (PH == 1) { pg8::Gemm g{(const bf16_t*)P.out, (const bf16_t*)(P.ws + WS_WINT), NTOK, 8192, 1024, 1024, 1024}; pg8::StaticOrder S; S.init(NTOK, 8192, gridDim.x, blockIdx.x);
        EpiProj E{(bf16_t*)(P.ws + WS_PJ)}; pg8::gemm_phase<EpiProj>(lds, g, S, E); }
    if constexpr (PH == 2) phase_gla_pre(P, lds, dry);
    if constexpr (PH == 3) phase_scan_and_mixer(P, lds, dry);
    if constexpr (PH == 4) { pg8::Gemm g{(const bf16_t*)P.out, (const bf16_t*)(P.ws + WS_WABT), NTOK, 1024, 2048, 2048, 2048}; pg8::StaticOrder S; S.init(NTOK, 1024, gridDim.x, blockIdx.x);
        EpiMerged E{(bf16_t*)(P.ws + WS_PJ)}; pg8::gemm_phase<EpiMerged>(lds, g, S, E); }
    if constexpr (PH == 5) { pg8::Gemm g{(const bf16_t*)(P.ws + WS_PJ) + T_GV, (const bf16_t*)(P.ws + WS_WOT), NTOK, 1024, 1024, 1024, 1024}; pg8::StaticOrder S; S.init(NTOK, 1024, gridDim.x, blockIdx.x);
        EpiOutNorm E{P.x, P.out, P.final_norm_g, (unsigned*)(P.ws + WS_XB), (unsigned*)(P.ws + WS_CNT)}; pg8::gemm_phase<EpiOutNorm>(lds, g, S, E); }
    if constexpr (PH == 6) phase_final_norm(P, dry);
}

template <int PH> __global__ void __launch_bounds__(512, 2) k_phase(Params P) {
    extern __shared__ __attribute__((aligned(16))) unsigned char shm[];
    run_phase<PH>(P, (LAS unsigned char*)shm, false);
}

__device__ __forceinline__ void grid_barrier(unsigned* ctr, unsigned target) {
    asm volatile("s_waitcnt vmcnt(0)" ::: "memory");
    __syncthreads();
    if (threadIdx.x == 0) {
        __builtin_amdgcn_fence(__ATOMIC_RELEASE, "agent"); asm volatile("s_waitcnt vmcnt(0)" ::: "memory");
        __hip_atomic_fetch_add(ctr, 1u, __ATOMIC_RELAXED, __HIP_MEMORY_SCOPE_AGENT);
        unsigned spins = 0;
        while (__hip_atomic_load(ctr, __ATOMIC_RELAXED, __HIP_MEMORY_SCOPE_AGENT) < target && ++spins < (1u << 24)) __builtin_amdgcn_s_sleep(4);
        __builtin_amdgcn_fence(__ATOMIC_ACQUIRE, "agent"); asm volatile("s_waitcnt vmcnt(0)" ::: "memory");
    }
    __syncthreads();
}
#define XB_TMO      128
#define XB_XCNT(j)  (256  + 64 * (j))
#define XB_XSUB(j)  (1280 + 64 * (j))
#define XB_XGEN(j)  (2304 + 64 * (j))
#define XB_TOP      3328
#define XB_TOPGEN   3392
#define XCD_BAR_WORDS 3456
#define XB_SPIN_CAP (1u << 20)
__device__ __forceinline__ unsigned xb_ld(unsigned* p)              { return __hip_atomic_load(p, __ATOMIC_RELAXED, __HIP_MEMORY_SCOPE_AGENT); }
__device__ __forceinline__ unsigned xb_add(unsigned* p, unsigned v) { return __hip_atomic_fetch_add(p, v, __ATOMIC_RELAXED, __HIP_MEMORY_SCOPE_AGENT); }
__device__ __forceinline__ unsigned xb_xcc_id() { return (unsigned)__builtin_amdgcn_s_getreg((3 << 11) | 20) & 0xFu; }
#define XB_SPIN(cond, bar) do { unsigned _sp = 0; while (cond) { __builtin_amdgcn_s_sleep(1); \
    if ((++_sp & 255u) == 0u) { if (xb_ld(&(bar)[XB_TMO])) break; if (_sp > XB_SPIN_CAP) { atomicAdd(&(bar)[XB_TMO], 1u); break; } } } } while (0)
struct XcdBarrier { unsigned* bar; unsigned x; volatile LAS unsigned* st; };
__device__ __forceinline__ XcdBarrier xcd_barrier_post(unsigned* bar, volatile LAS unsigned* st) {
    XcdBarrier b; b.bar = bar; b.x = xb_xcc_id(); b.st = st;
    if (threadIdx.x == 0) (void)xb_add(&bar[XB_XCNT(b.x)], 1u);
    return b;
}
__device__ __forceinline__ void xcd_barrier_complete(unsigned* bar, unsigned x, unsigned& nloc, unsigned& nx) {
    const unsigned G = gridDim.x * gridDim.y * gridDim.z;
    unsigned sum, cnt, mine, sp = 0u;
    for (;;) {
        sum = 0u; cnt = 0u; mine = 0u;
#pragma unroll
        for (unsigned j = 0; j < 16; ++j) { const unsigned c = xb_ld(&bar[XB_XCNT(j)]); sum += c; cnt += (c > 0u) ? 1u : 0u; mine = (j == x) ? c : mine; }
        if (sum == G) break;
        __builtin_amdgcn_s_sleep(1);
        if ((++sp & 255u) == 0u) { if (xb_ld(&bar[XB_TMO])) break; if (sp > XB_SPIN_CAP) { atomicAdd(&bar[XB_TMO], 1u); break; } }
    }
    nloc = mine > 0u ? mine : 1u; nx = cnt > 0u ? cnt : 1u;
}
__device__ __forceinline__ void xcd_barrier(const XcdBarrier& b) {
    asm volatile("s_waitcnt vmcnt(0)" ::: "memory");
    __syncthreads();
    if (threadIdx.x == 0) {
        unsigned* bar = b.bar;
        __builtin_amdgcn_s_waitcnt(0);
        unsigned nloc = b.st[0], nx = b.st[1];
        if (nloc == 0u) { xcd_barrier_complete(bar, b.x, nloc, nx); b.st[0] = nloc; b.st[1] = nx; }
        const unsigned old = xb_add(&bar[XB_XSUB(b.x)], 1u);
        const unsigned gen = old / nloc;
        if (old + 1u == (gen + 1u) * nloc) {
            __builtin_amdgcn_fence(__ATOMIC_RELEASE, "agent");
            asm volatile("s_waitcnt vmcnt(0)" ::: "memory");
            const unsigned og = xb_add(&bar[XB_TOP], 1u);
            const unsigned tg = og / nx;
            if (og + 1u == (tg + 1u) * nx) xb_add(&bar[XB_TOPGEN], 1u);
            else XB_SPIN(xb_ld(&bar[XB_TOPGEN]) == tg, bar);
            __builtin_amdgcn_fence(__ATOMIC_ACQUIRE, "agent");
            xb_add(&bar[XB_XGEN(b.x)], 1u);
            asm volatile("s_waitcnt vmcnt(0)" ::: "memory");
        } else {
            XB_SPIN(xb_ld(&bar[XB_XGEN(b.x)]) == gen, bar);
            __builtin_amdgcn_fence(__ATOMIC_ACQUIRE, "agent");
            asm volatile("s_waitcnt vmcnt(0)" ::: "memory");
        }
    }
    __syncthreads();
}
constexpr unsigned BAR_MAGIC = 0x600DF00Du;
__device__ __forceinline__ void first_barrier(unsigned* flags  ) {
    asm volatile("s_waitcnt vmcnt(0)" ::: "memory");
    __syncthreads();
    const unsigned G = gridDim.x;
    if (threadIdx.x == 0) {
        __builtin_amdgcn_fence(__ATOMIC_RELEASE, "agent"); asm volatile("s_waitcnt vmcnt(0)" ::: "memory");
        __hip_atomic_store(flags + blockIdx.x, BAR_MAGIC, __ATOMIC_RELAXED, __HIP_MEMORY_SCOPE_AGENT);
    }
    if (blockIdx.x == 0 && threadIdx.x < 64) {
        unsigned spins = 0;
        for (;;) { bool ok = true;
            for (unsigned i = threadIdx.x; i < G; i += 64) ok = ok && (__hip_atomic_load(flags + i, __ATOMIC_RELAXED, __HIP_MEMORY_SCOPE_AGENT) == BAR_MAGIC);
            if (__all(ok) || ++spins > (1u << 22)) break;
            __builtin_amdgcn_s_sleep(1); }
        if (threadIdx.x == 0) __hip_atomic_store(flags + 1024, BAR_MAGIC, __ATOMIC_RELAXED, __HIP_MEMORY_SCOPE_AGENT);
    }
    if (threadIdx.x == 0) {
        unsigned spins = 0;
        while (__hip_atomic_load(flags + 1024, __ATOMIC_RELAXED, __HIP_MEMORY_SCOPE_AGENT) != BAR_MAGIC && ++spins < (1u << 24)) __builtin_amdgcn_s_sleep(1);
        __builtin_amdgcn_fence(__ATOMIC_ACQUIRE, "agent"); asm volatile("s_waitcnt vmcnt(0)" ::: "memory");
    }
    __syncthreads();
}
__device__ __forceinline__ void first_barrier_reset(unsigned* flags) {
    if (threadIdx.x == 0) { flags[blockIdx.x] = 0u; if (blockIdx.x == 0) flags[1024] = 0u; }
}
#if defined(PROBE_MASK)
#define RUN(i) do { if ((PROBE_MASK >> (i)) & 1) { run_phase<i>(P, lds, true); SYNC(); } run_phase<i>(P, lds, false); SYNC(); } while (0)
#else
#define RUN(i) do { run_phase<i>(P, lds, false); SYNC(); } while (0)
#endif
__global__ void __launch_bounds__(512, 2) k_mega(Params P) {
    extern __shared__ __attribute__((aligned(16))) unsigned char shm[];
    LAS unsigned char* lds = (LAS unsigned char*)shm;
    cg::grid_group grid = cg::this_grid();
    unsigned nbar = 0; unsigned* bar = (unsigned*)P.ws;
#define SYNC() xcd_barrier(xb)
    if (P.pad != 0) grid.sync();
    unsigned* fb = (unsigned*)(P.ws + 4096);
    volatile LAS unsigned* xst = (volatile LAS unsigned*)(lds + LDS_BYTES - 16);
    if (threadIdx.x == 0) { xst[0] = 0u; xst[1] = 0u; }
    run_phase<0>(P, lds, false); first_barrier(fb);
    const XcdBarrier xb = xcd_barrier_post((unsigned*)(P.ws + 16384), xst);
    RUN(1); first_barrier_reset(fb); RUN(2); RUN(3); RUN(4);
#if defined(PROBE_MASK)
    if ((PROBE_MASK >> 5) & 1) { run_phase<5>(P, lds, true); SYNC(); }
#endif
    run_phase<5>(P, lds, false);
}

template <class F> static void launch_one(F f, int grid, const Params& p, hipStream_t stream) {
    hipFuncSetAttribute((const void*)f, hipFuncAttributeMaxDynamicSharedMemorySize, LDS_BYTES);
    hipLaunchKernelGGL(f, dim3(grid), dim3(512), LDS_BYTES, stream, p);
}

extern "C" void kernel_launch(void* const* d_in, const int* in_sizes, int n_in, void* d_out, int out_size, void* d_ws, size_t ws_size, hipStream_t stream) {
    if (n_in != 14 || ws_size < WS_END) { fprintf(stderr, "kernel_launch: unexpected n_in %d or ws_size %zu (need %zu)\n", n_in, ws_size, (size_t)WS_END); return; }
    Params p{};
    p.x = (const float*)d_in[0]; p.norm_g = (const float*)d_in[1]; p.w_in = (const float*)d_in[2]; p.ln_v_g = (const float*)d_in[3]; p.ln_v_b = (const float*)d_in[4];
    p.w_spatial = (const float*)d_in[5]; p.b_spatial = (const float*)d_in[6]; p.w_gate_up = (const float*)d_in[7]; p.b_gate_up = (const float*)d_in[8]; p.gla_norm_g = (const float*)d_in[9];
    p.w_branch_a = (const float*)d_in[10]; p.w_branch_b = (const float*)d_in[11]; p.w_out = (const float*)d_in[12]; p.final_norm_g = (const float*)d_in[13];
    p.out = (float*)d_out; p.ws = (unsigned char*)d_ws; p.mask = 0; p.pad = 0;
#if defined(PROBE_MASK)
    p.mask = PROBE_MASK;
#endif
    static int grid = 0;
    if (grid == 0) {
        int dev = 0, cus = 0, per_cu = 0;
        hipGetDevice(&dev); hipDeviceGetAttribute(&cus, hipDeviceAttributeMultiprocessorCount, dev);
        hipFuncSetAttribute((const void*)k_mega, hipFuncAttributeMaxDynamicSharedMemorySize, LDS_BYTES);
        hipOccupancyMaxActiveBlocksPerMultiprocessor(&per_cu, (const void*)k_mega, 512, LDS_BYTES);
        (void)per_cu;
        grid = cus;
    }
#if defined(MULTI_LAUNCH)
    launch_one(k_phase<0>, grid, p, stream); launch_one(k_phase<1>, grid, p, stream); launch_one(k_phase<2>, grid, p, stream); launch_one(k_phase<3>, grid, p, stream);
    launch_one(k_phase<4>, grid, p, stream); launch_one(k_phase<5>, grid, p, stream); launch_one(k_phase<6>, grid, p, stream);
#else
    void* args[] = {&p};
    hipError_t e = hipLaunchCooperativeKernel((void*)k_mega, dim3(grid), dim3(512), args, LDS_BYTES, stream);
    if (e != hipSuccess) fprintf(stderr, "cooperative launch failed: %s (grid %d)\n", hipGetErrorString(e), grid);
#endif
}
```
